# Optimizing an MI355X kernel written in HIP

```python
import jax, jax.numpy as jnp
from jax import lax
import numpy as np

D_MODEL = 2048
BATCH = 1
SEQ = 16384
DEPTH = 1

MEM_LEN = 256
EPS = 1e-6
D_FF = 5504

RW_HEADS = 16
RW_HEAD_DIM = 64
RW_WIDTH = RW_HEADS * RW_HEAD_DIM
RW_DECAY_LORA = 64
RW_ICLR_LORA = 64
RW_GATE_LORA = 160
RW_GN_EPS = 64e-5
RW_SPLITS = (RW_WIDTH, RW_WIDTH, RW_WIDTH, RW_DECAY_LORA, RW_ICLR_LORA, RW_GATE_LORA)
RW_COLS = 3 * RW_WIDTH + RW_DECAY_LORA + RW_ICLR_LORA + RW_GATE_LORA

NSA_HEADS = 16
NSA_KV_GROUPS = 4
NSA_HPG = NSA_HEADS // NSA_KV_GROUPS
NSA_HEAD_DIM = 64
NSA_WIDTH = NSA_HEADS * NSA_HEAD_DIM
NSA_KV_WIDTH = NSA_KV_GROUPS * NSA_HEAD_DIM
NSA_SPLITS = (NSA_WIDTH, NSA_KV_WIDTH, NSA_KV_WIDTH, NSA_KV_WIDTH, NSA_KV_WIDTH, NSA_KV_WIDTH, NSA_KV_WIDTH, 3 * NSA_HEADS)
NSA_COLS = NSA_WIDTH + 6 * NSA_KV_WIDTH + 3 * NSA_HEADS
CMP_BLOCK = 32
CMP_STRIDE = 16
CMP_HIDDEN = 128
SEL_BLOCK = 64
SEL_TOPK = 16
WINDOW = 512
Q_BLOCK = 128
FORCE_BONUS = 1000.0

ROPE_THETA = 500000.0
ROPE_DIM = NSA_HEAD_DIM // 4

MIX_WIDTH = RW_WIDTH + NSA_WIDTH
IN_COLS = RW_COLS + NSA_COLS

MEM_HEADS = 4
MEM_HEAD_DIM = 128
MEM_WIDTH = MEM_HEADS * MEM_HEAD_DIM

kernel_name = 'hymba_rwkv7_nsa_macaron_memory'

F32 = jnp.float32


def rmsnorm(x, g):
    xf = x.astype(F32)
    y = xf * lax.rsqrt(jnp.mean(xf * xf, axis=-1, keepdims=True) + EPS)
    return (y * g.astype(F32)).astype(x.dtype)


def swiglu(x, w_gate, w_up, w_down):
    return (jax.nn.silu(x @ w_gate) * (x @ w_up)) @ w_down


def split_cols(x, sizes):
    offs = np.cumsum(np.array(sizes))[:-1].tolist()
    return jnp.split(x, offs, axis=-1)


def token_shift(f, mu):
    prev = jnp.pad(f, ((0, 0), (1, 0), (0, 0)))[:, :-1]
    return f + mu * (prev - f)


def partial_rope(x, pos):
    half = ROPE_DIM // 2
    inv_freq = ROPE_THETA ** (-jnp.arange(half, dtype=F32) * 2.0 / ROPE_DIM)
    ang = pos.astype(F32)[:, None] * inv_freq[None, :]
    cos = jnp.cos(ang)[None, :, None, :]
    sin = jnp.sin(ang)[None, :, None, :]
    x1 = x[..., :half].astype(F32)
    x2 = x[..., half:ROPE_DIM].astype(F32)
    rot = jnp.concatenate([x1 * cos - x2 * sin, x2 * cos + x1 * sin], axis=-1).astype(x.dtype)
    return jnp.concatenate([rot, x[..., ROPE_DIM:]], axis=-1)


def masked_softmax(s, mask):
    s = jnp.where(mask, s.astype(F32), -1e30)
    return jax.nn.softmax(s, axis=-1) * mask


def rwkv7_group(f, mu, w0, w_up, a0, a_up, g_up, k_k, k_a, r_k, ln_w, ln_b):
    B, S, _ = f.shape
    H, N = RW_HEADS, RW_HEAD_DIM
    f = token_shift(f, mu)
    r, k, v, wd, ad, gd = split_cols(f, RW_SPLITS)
    w_log = -jax.nn.softplus(-(w0 + jnp.tanh(wd) @ w_up)) - 0.5
    decay = jnp.exp(-jnp.exp(w_log.astype(F32)))
    a = jax.nn.sigmoid(a0 + ad @ a_up)
    g = jax.nn.sigmoid(gd) @ g_up
    heads = lambda t: t.reshape(B, S, H, N)
    kk = heads(k * k_k).astype(F32)
    kk = kk / jnp.maximum(jnp.sqrt(jnp.sum(kk * kk, axis=-1, keepdims=True)), 1e-12)
    k = k * (1.0 + (a - 1.0) * k_a)
    r_h, k_h, v_h, a_h = heads(r), heads(k), heads(v), heads(a)
    xs = tuple(jnp.swapaxes(t.astype(F32), 0, 1) for t in (r_h, heads(decay), k_h, v_h, kk, a_h))

    def step(state, inp):
        r_t, w_t, k_t, v_t, kk_t, a_t = inp
        sa = jnp.einsum('bhvk,bhk->bhv', state, -kk_t)
        state = (state * w_t[:, :, None, :]
                 + sa[..., None] * (kk_t * a_t)[:, :, None, :]
                 + v_t[..., None] * k_t[:, :, None, :])
        return state, jnp.einsum('bhvk,bhk->bhv', state, r_t)

    state0 = jnp.zeros((B, H, N, N), F32)
    _, y = lax.scan(step, state0, xs)
    y = jnp.swapaxes(y, 0, 1)
    mean = jnp.mean(y, axis=-1, keepdims=True)
    var = jnp.mean(jnp.square(y - mean), axis=-1, keepdims=True)
    y = ((y - mean) * lax.rsqrt(var + RW_GN_EPS)).reshape(B, S, RW_WIDTH) * ln_w + ln_b
    bonus = jnp.sum(r_h * k_h * r_k, axis=-1, keepdims=True) * v_h
    y = y + bonus.reshape(B, S, RW_WIDTH)
    return (y * g).astype(f.dtype)


def compress(x, pe, w1, w2):
    B, S, G, Dh = x.shape
    n_chunks = S // CMP_STRIDE
    ratio = CMP_BLOCK // CMP_STRIDE
    n_cmp = n_chunks - ratio + 1
    chunks = x.reshape(B, n_chunks, CMP_STRIDE, G, Dh)
    blocks = jnp.concatenate([chunks[:, i:i + n_cmp] for i in range(ratio)], axis=2)
    blocks = blocks + pe[None, None, :, None, :]
    blocks = blocks.transpose(0, 3, 1, 2, 4).reshape(B, G, n_cmp, CMP_BLOCK * Dh)
    return jax.nn.gelu(blocks @ w1) @ w2


def nsa_group(f, pos, cmp_pe_k, cmp_w1_k, cmp_w2_k, cmp_pe_v, cmp_w1_v, cmp_w2_v):
    B, S, _ = f.shape
    G, HPG, Dh = NSA_KV_GROUPS, NSA_HPG, NSA_HEAD_DIM
    q, kc, vc, ks, vs, kw, vw, gl = split_cols(f, NSA_SPLITS)
    kv = lambda t: t.reshape(B, S, G, Dh)
    q = q.reshape(B, S, NSA_HEADS, Dh)
    to_bghsd = lambda t: t.reshape(B, S, G, HPG, Dh).transpose(0, 2, 3, 1, 4)
    q_nope = to_bghsd(q)
    q_rope = to_bghsd(partial_rope(q, pos))

    k_cmp = compress(kv(kc), cmp_pe_k, cmp_w1_k, cmp_w2_k)
    v_cmp = compress(kv(vc), cmp_pe_v, cmp_w1_v, cmp_w2_v)
    n_cmp = k_cmp.shape[2]
    cmp_start = jnp.arange(n_cmp) * CMP_STRIDE
    cmp_end = cmp_start + (CMP_BLOCK - 1)
    n_sel = S // SEL_BLOCK
    sel_start = jnp.arange(n_sel) * SEL_BLOCK
    overlap = ((cmp_start[:, None] < sel_start[None, :] + SEL_BLOCK)
               & (cmp_end[:, None] >= sel_start[None, :])).astype(F32)

    to_blocks = lambda t: t.reshape(B, n_sel, SEL_BLOCK, G, Dh).transpose(0, 3, 1, 2, 4)
    k_sel_blocks = to_blocks(partial_rope(kv(ks), pos))
    v_sel_blocks = to_blocks(kv(vs))
    pad_front = lambda t: jnp.pad(t, ((0, 0), (WINDOW, 0), (0, 0), (0, 0))).transpose(0, 2, 1, 3)
    k_win = pad_front(partial_rope(kv(kw), pos))
    v_win = pad_front(kv(vw))
    gates = jax.nn.sigmoid(gl.astype(F32)).reshape(B, S, 3, G, HPG).transpose(0, 2, 3, 4, 1)

    top_n = min(SEL_TOPK, n_sel)
    scale = Dh ** -0.5
    gather = jax.vmap(jax.vmap(lambda blk, ix: blk[ix]))

    def query_block(i):
        q0 = i * Q_BLOCK
        t = q0 + jnp.arange(Q_BLOCK)
        qn = lax.dynamic_slice_in_dim(q_nope, q0, Q_BLOCK, axis=3)
        qr = lax.dynamic_slice_in_dim(q_rope, q0, Q_BLOCK, axis=3)
        s_c = jnp.einsum('bghqd,bgnd->bghqn', qn, k_cmp) * scale
        p_c = masked_softmax(s_c, cmp_end[None, :] <= t[:, None])
        o_c = jnp.einsum('bghqn,bgnd->bghqd', p_c, v_cmp)
        imp = jnp.einsum('bghqn,nj->bgqj', p_c, overlap)
        cur = (t // SEL_BLOCK)[:, None]
        jj = jnp.arange(n_sel)[None, :]
        forced = (jj == 0) | (jj == cur) | (jj == cur - 1)
        score = jnp.where(jj <= cur, imp + FORCE_BONUS * forced, -1.0)
        _, idx = lax.top_k(score, top_n)
        k_s = gather(k_sel_blocks, idx).reshape(B, G, Q_BLOCK, top_n * SEL_BLOCK, Dh)
        v_s = gather(v_sel_blocks, idx).reshape(B, G, Q_BLOCK, top_n * SEL_BLOCK, Dh)
        pos_s = (idx[..., None] * SEL_BLOCK + jnp.arange(SEL_BLOCK)).reshape(B, G, Q_BLOCK, top_n * SEL_BLOCK)
        s_s = jnp.einsum('bghqd,bgqkd->bghqk', qr, k_s) * scale
        p_s = masked_softmax(s_s, (pos_s <= t[:, None])[:, :, None])
        o_s = jnp.einsum('bghqk,bgqkd->bghqd', p_s, v_s)
        k_w = lax.dynamic_slice_in_dim(k_win, q0, Q_BLOCK + WINDOW, axis=2)
        v_w = lax.dynamic_slice_in_dim(v_win, q0, Q_BLOCK + WINDOW, axis=2)
        pos_w = q0 - WINDOW + jnp.arange(Q_BLOCK + WINDOW)
        diff = t[:, None] - pos_w[None, :]
        mask_w = (diff >= 0) & (diff < WINDOW) & (pos_w[None, :] >= 0)
        s_w = jnp.einsum('bghqd,bgkd->bghqk', qr, k_w) * scale
        p_w = masked_softmax(s_w, mask_w)
        o_w = jnp.einsum('bghqk,bgkd->bghqd', p_w, v_w)
        g = lax.dynamic_slice_in_dim(gates, q0, Q_BLOCK, axis=4)[..., None]
        o = g[:, 0] * o_c + g[:, 1] * o_s + g[:, 2] * o_w
        return o.transpose(0, 3, 1, 2, 4).reshape(B, Q_BLOCK, NSA_WIDTH)

    out = lax.map(query_block, jnp.arange(S // Q_BLOCK))
    return out.transpose(1, 0, 2, 3).reshape(B, S, NSA_WIDTH).astype(f.dtype)


def memory_cross_attention(h, mem, w_q, w_kv, w_o):
    B, S, _ = h.shape
    M = mem.shape[1]
    q = (h @ w_q).reshape(B, S, MEM_HEADS, MEM_HEAD_DIM)
    k, v = jnp.split(mem @ w_kv, 2, axis=-1)
    k = k.reshape(B, M, MEM_HEADS, MEM_HEAD_DIM)
    v = v.reshape(B, M, MEM_HEADS, MEM_HEAD_DIM)
    s = jnp.einsum('bshd,bmhd->bhsm', q, k).astype(F32) * (MEM_HEAD_DIM ** -0.5)
    p = jax.nn.softmax(s, axis=-1)
    o = jnp.einsum('bhsm,bmhd->bshd', p, v).astype(h.dtype).reshape(B, S, MEM_WIDTH)
    return o @ w_o


def setup_inputs(seed: int = 0) -> dict:
    key = jax.random.key(seed)
    ks = iter(jax.random.split(key, 48))
    nrm = lambda shape, scale: jax.random.normal(next(ks), shape, F32) * scale
    gain = lambda n: 1.0 + nrm((n,), 0.05)
    uni = lambda shape, lo, hi: jax.random.uniform(next(ks), shape, F32, lo, hi)
    d = D_MODEL
    return {
        'x': nrm((BATCH, SEQ, d), 1.0),
        'mem': nrm((BATCH, MEM_LEN, d), 1.0),
        'ffn1_pre_g': gain(d),
        'ffn1_w_gate': nrm((d, D_FF), d ** -0.5),
        'ffn1_w_up': nrm((d, D_FF), d ** -0.5),
        'ffn1_w_down': nrm((D_FF, d), D_FF ** -0.5),
        'ffn1_post_g': gain(d),
        'mix_pre_g': gain(d),
        'w_in': nrm((d, IN_COLS), d ** -0.5),
        'rw_mu': uni((RW_COLS,), 0.0, 1.0),
        'rw_w0': uni((RW_WIDTH,), -6.0, 1.0),
        'rw_w_up': nrm((RW_DECAY_LORA, RW_WIDTH), 0.5 * RW_DECAY_LORA ** -0.5),
        'rw_a0': nrm((RW_WIDTH,), 0.1),
        'rw_a_up': nrm((RW_ICLR_LORA, RW_WIDTH), 0.5 * RW_ICLR_LORA ** -0.5),
        'rw_g_up': nrm((RW_GATE_LORA, RW_WIDTH), RW_GATE_LORA ** -0.5),
        'rw_k_k': 0.85 + nrm((RW_WIDTH,), 0.05),
        'rw_k_a': 1.0 + nrm((RW_WIDTH,), 0.05),
        'rw_r_k': nrm((RW_HEADS, RW_HEAD_DIM), 0.1),
        'rw_ln_w': gain(RW_WIDTH),
        'rw_ln_b': nrm((RW_WIDTH,), 0.01),
        'cmp_pe_k': nrm((CMP_BLOCK, NSA_HEAD_DIM), 0.02),
        'cmp_w1_k': nrm((CMP_BLOCK * NSA_HEAD_DIM, CMP_HIDDEN), (CMP_BLOCK * NSA_HEAD_DIM) ** -0.5),
        'cmp_w2_k': nrm((CMP_HIDDEN, NSA_HEAD_DIM), CMP_HIDDEN ** -0.5),
        'cmp_pe_v': nrm((CMP_BLOCK, NSA_HEAD_DIM), 0.02),
        'cmp_w1_v': nrm((CMP_BLOCK * NSA_HEAD_DIM, CMP_HIDDEN), (CMP_BLOCK * NSA_HEAD_DIM) ** -0.5),
        'cmp_w2_v': nrm((CMP_HIDDEN, NSA_HEAD_DIM), CMP_HIDDEN ** -0.5),
        'w_out': nrm((MIX_WIDTH, d), MIX_WIDTH ** -0.5),
        'mix_post_g': gain(d),
        'mem_pre_g': gain(d),
        'mem_norm_g': gain(d),
        'mem_w_q': nrm((d, MEM_WIDTH), d ** -0.5),
        'mem_w_kv': nrm((d, 2 * MEM_WIDTH), d ** -0.5),
        'mem_w_o': nrm((MEM_WIDTH, d), MEM_WIDTH ** -0.5),
        'mem_post_g': gain(d),
        'ffn2_pre_g': gain(d),
        'ffn2_w_gate': nrm((d, D_FF), d ** -0.5),
        'ffn2_w_up': nrm((d, D_FF), d ** -0.5),
        'ffn2_w_down': nrm((D_FF, d), D_FF ** -0.5),
        'ffn2_post_g': gain(d),
    }


def reference(x, mem,
              ffn1_pre_g, ffn1_w_gate, ffn1_w_up, ffn1_w_down, ffn1_post_g,
              mix_pre_g, w_in,
              rw_mu, rw_w0, rw_w_up, rw_a0, rw_a_up, rw_g_up, rw_k_k, rw_k_a, rw_r_k, rw_ln_w, rw_ln_b,
              cmp_pe_k, cmp_w1_k, cmp_w2_k, cmp_pe_v, cmp_w1_v, cmp_w2_v,
              w_out, mix_post_g,
              mem_pre_g, mem_norm_g, mem_w_q, mem_w_kv, mem_w_o, mem_post_g,
              ffn2_pre_g, ffn2_w_gate, ffn2_w_up, ffn2_w_down, ffn2_post_g):
    S = x.shape[1]
    pos = jnp.arange(S, dtype=jnp.int32)
    mem_n = rmsnorm(mem, mem_norm_g)
    h = x
    for _ in range(DEPTH):
        h = h + 0.5 * rmsnorm(swiglu(rmsnorm(h, ffn1_pre_g), ffn1_w_gate, ffn1_w_up, ffn1_w_down), ffn1_post_g)
        feats = rmsnorm(h, mix_pre_g) @ w_in
        f_rw, f_nsa = jnp.split(feats, [RW_COLS], axis=-1)
        y_rw = rwkv7_group(f_rw, rw_mu, rw_w0, rw_w_up, rw_a0, rw_a_up, rw_g_up,
                           rw_k_k, rw_k_a, rw_r_k, rw_ln_w, rw_ln_b)
        y_nsa = nsa_group(f_nsa, pos, cmp_pe_k, cmp_w1_k, cmp_w2_k,
                          cmp_pe_v, cmp_w1_v, cmp_w2_v)
        y = jnp.concatenate([y_rw, y_nsa], axis=-1) @ w_out
        h = h + rmsnorm(y, mix_post_g)
        m = memory_cross_attention(rmsnorm(h, mem_pre_g), mem_n, mem_w_q, mem_w_kv, mem_w_o)
        h = h + rmsnorm(m, mem_post_g)
        h = h + 0.5 * rmsnorm(swiglu(rmsnorm(h, ffn2_pre_g), ffn2_w_gate, ffn2_w_up, ffn2_w_down), ffn2_post_g)
    return h
```

```cpp
#include <hip/hip_runtime.h>
#include <hip/hip_cooperative_groups.h>
#include <cstdio>
namespace cg = cooperative_groups;


#define LAS __attribute__((address_space(3)))
typedef unsigned short bf16_t;
typedef short bf16x8 __attribute__((ext_vector_type(8)));
typedef float f32x4 __attribute__((ext_vector_type(4)));
typedef float f32x2 __attribute__((ext_vector_type(2)));
typedef unsigned u32x4 __attribute__((ext_vector_type(4)));
typedef unsigned u32x2 __attribute__((ext_vector_type(2)));

constexpr int S_ = 16384, D_ = 2048, FF_ = 5504, MEM_ = 256;
constexpr int RW_COLS = 3360, NSA_COLS = 2608, IN_COLS = 5968, IN_PAD = 6144;
constexpr int LORA_K = 384, LORA_N = 3072;
constexpr float EPS_ = 1e-6f;

constexpr size_t SZ_WGU = (size_t)2 * FF_ * D_ * 2, SZ_WD = (size_t)D_ * FF_ * 2;
constexpr size_t OFF_WGU = 0;
constexpr size_t OFF_WD = OFF_WGU + SZ_WGU;
constexpr size_t OFF_WIN = OFF_WD + SZ_WD;
constexpr size_t OFF_WOUT = OFF_WIN + (size_t)IN_PAD * D_ * 2;
constexpr size_t OFF_WMQ = OFF_WOUT + (size_t)D_ * D_ * 2;
constexpr size_t OFF_WMO = OFF_WMQ + (size_t)512 * D_ * 2;
constexpr size_t OFF_WMKV = OFF_WMO + (size_t)D_ * 512 * 2;
constexpr size_t OFF_WLORA = OFF_WMKV + (size_t)1024 * D_ * 2;
constexpr size_t OFF_WC1K = OFF_WLORA + (size_t)LORA_N * LORA_K * 2;
constexpr size_t OFF_WC1V = OFF_WC1K + (size_t)128 * 2048 * 2;
constexpr size_t OFF_WC2K = OFF_WC1V + (size_t)128 * 2048 * 2;
constexpr size_t OFF_WC2V = OFF_WC2K + (size_t)64 * 128 * 2;
constexpr size_t OFF_MEMN = OFF_WC2V + (size_t)64 * 128 * 2;
constexpr size_t OFF_KM = OFF_MEMN + (size_t)MEM_ * D_ * 2;
constexpr size_t OFF_VMT = OFF_KM + (size_t)MEM_ * 512 * 2;
constexpr size_t OFF_KCMP = OFF_VMT + (size_t)MEM_ * 512 * 2;
constexpr size_t OFF_VCMPT = OFF_KCMP + (size_t)4 * 1024 * 64 * 2;
constexpr size_t OFF_ROPE = OFF_VCMPT + (size_t)4 * 1024 * 64 * 2;
constexpr size_t OFF_CTR = OFF_ROPE + (size_t)S_ * 16 * 4;
constexpr size_t OFF_XN = ((OFF_CTR + 4096 + 1048575) / 1048576) * 1048576;
constexpr size_t OFF_ACT = OFF_XN + (size_t)S_ * D_ * 2;
constexpr size_t OFF_Y = OFF_ACT + (size_t)S_ * IN_PAD * 2;
constexpr size_t WS_END = OFF_Y + (size_t)S_ * D_ * 4;
constexpr size_t OFF_KSR = 0;
constexpr size_t OFF_KWR = OFF_KSR + (size_t)S_ * 256 * 2;
constexpr size_t OFF_VST = OFF_KWR + (size_t)S_ * 256 * 2;
constexpr size_t OFF_VWT = OFF_VST + (size_t)S_ * 256 * 2;
constexpr size_t OFF_XL = OFF_VWT + (size_t)S_ * 256 * 2;
constexpr size_t OFF_KN2 = OFF_XL + (size_t)S_ * LORA_K * 2;
constexpr size_t OFF_MIXEND = OFF_KN2 + (size_t)S_ * 16 * 4;
static_assert(OFF_MIXEND <= OFF_WIN, "mix temporaries overflow the FFN weight region");
constexpr size_t OFF_LORA = OFF_Y;
constexpr size_t OFF_YRAW = OFF_Y + (size_t)S_ * LORA_N * 2;
constexpr size_t OFF_QM = OFF_ACT;
constexpr size_t OFF_OM = OFF_ACT + (size_t)S_ * 512 * 2;

struct Params {
    const float* in[39];
    float* out;
    unsigned char* ws;
};

__device__ __forceinline__ float bf2f(bf16_t b) { return __uint_as_float(((unsigned)b) << 16); }
__device__ __forceinline__ unsigned pk2(float lo, float hi) { unsigned r; asm("v_cvt_pk_bf16_f32 %0, %1, %2" : "=v"(r) : "v"(lo), "v"(hi)); return r; }
__device__ __forceinline__ bf16_t f2bf(float f) { return (bf16_t)(pk2(f, 0.f) & 0xffffu); }
template <int CTRL> __device__ __forceinline__ float dppf(float x) { return __int_as_float(__builtin_amdgcn_update_dpp(0, __float_as_int(x), CTRL, 0xf, 0xf, false)); }
__device__ __forceinline__ float rowsum16(float x) { x += dppf<0x128>(x); x += dppf<0x124>(x); x += dppf<0x122>(x); x += dppf<0x121>(x); return x; }
__device__ __forceinline__ float rowmax16(float x) { x = fmaxf(x, dppf<0x128>(x)); x = fmaxf(x, dppf<0x124>(x)); x = fmaxf(x, dppf<0x122>(x)); x = fmaxf(x, dppf<0x121>(x)); return x; }
__device__ __forceinline__ float quad_allmax(float x) {
    auto r = __builtin_amdgcn_permlane32_swap(__float_as_uint(x), __float_as_uint(x), false, false); x = fmaxf(__uint_as_float(r[0]), __uint_as_float(r[1]));
    auto q = __builtin_amdgcn_permlane16_swap(__float_as_uint(x), __float_as_uint(x), false, false); return fmaxf(__uint_as_float(q[0]), __uint_as_float(q[1]));
}
__device__ __forceinline__ float quad_allsum(float x) {
    auto r = __builtin_amdgcn_permlane32_swap(__float_as_uint(x), __float_as_uint(x), false, false); x = __uint_as_float(r[0]) + __uint_as_float(r[1]);
    auto q = __builtin_amdgcn_permlane16_swap(__float_as_uint(x), __float_as_uint(x), false, false); return __uint_as_float(q[0]) + __uint_as_float(q[1]);
}
__device__ __forceinline__ float wave_sum(float v) { return quad_allsum(rowsum16(v)); }
__device__ __forceinline__ float wave_max(float v) { return quad_allmax(rowmax16(v)); }
template <int CTRL> __device__ __forceinline__ unsigned dppu(unsigned x) { return (unsigned)__builtin_amdgcn_update_dpp(0, (int)x, CTRL, 0xf, 0xf, false); }
__device__ __forceinline__ unsigned umax_(unsigned a, unsigned b) { return a > b ? a : b; }
__device__ __forceinline__ unsigned wave_max_u(unsigned x) {
    x = umax_(x, dppu<0x128>(x)); x = umax_(x, dppu<0x124>(x)); x = umax_(x, dppu<0x122>(x)); x = umax_(x, dppu<0x121>(x));
    auto r = __builtin_amdgcn_permlane32_swap(x, x, false, false); x = umax_(r[0], r[1]);
    auto q = __builtin_amdgcn_permlane16_swap(x, x, false, false); return umax_(q[0], q[1]);
}
__device__ __forceinline__ float sigmoidf_(float x) { return __builtin_amdgcn_rcpf(1.f + __expf(-x)); }
#define LDS_WAIT() asm volatile("s_waitcnt lgkmcnt(0)" ::: "memory")

namespace pg8 {
constexpr int BM = 256, BK = 64, HALF = 128, HTB = HALF * BK * 2, STAGE_BYTES = 8 * HTB, NXCD = 8, WGM = 8;
__host__ __device__ __forceinline__ int lds_byte(int r, int c) { const int st = (r >> 4) * 2 + (c >> 5), rr = r & 15, cc = c & 31, ob = rr * 64 + cc * 2; return st * 1024 + (ob ^ (((ob >> 9) & 1) << 5)); }
__host__ __device__ __forceinline__ void stage_rc(int b, int& R, int& C) { const int st = b / 1024, sb = b % 1024, swz = sb ^ (((sb >> 9) & 1) << 5); R = (st >> 1) * 16 + swz / 64; C = (st & 1) * 32 + (swz % 64) / 2; }
__host__ __device__ __forceinline__ int perm32(int rho) { const int n = rho >> 4, i = rho & 15; return 8 * (i >> 2) + 4 * n + (i & 3); }
struct Unit { int pm, pn; };
struct Gemm { const bf16_t* A; const bf16_t* Bt; int M, N, K; };
struct StaticOrder {
    int nM, nN, nwg, G, c;
    __device__ void init(int M, int N, int G_, int c_) { nM = M / BM; nN = N / BM; nwg = nM * nN; G = G_; c = c_; }
    __device__ bool next(int i, Unit& u) const {
        const long L = (long)i * G + c; if (L >= nwg) return false;
        int wgid = (int)L; { const int q = nwg / NXCD, r = nwg % NXCD, xcd = wgid % NXCD, off = wgid / NXCD; wgid = (xcd < r ? xcd * (q + 1) : r * (q + 1) + (xcd - r) * q) + off; }
        const int nig = WGM * nN, gid = wgid / nig, fm = gid * WGM, gsz = (nM - fm) < WGM ? (nM - fm) : WGM;
        u.pm = fm + ((wgid % nig) % gsz); u.pn = (wgid % nig) / gsz; return true;
    }
};

template <class Epi>
__device__ __forceinline__ void gemm_phase(LAS unsigned char* lds, const Gemm g, const StaticOrder& S, const Epi& E, const int wave_s) {
    int lane; asm volatile("v_mbcnt_lo_u32_b32 %0, -1, 0\n\tv_mbcnt_hi_u32_b32 %0, -1, %0" : "=v"(lane));
    const int wid = wave_s; const int tid = wid * 64 + lane; const int wr = wid >> 2, wc = wid & 3, fr = lane & 15, fq = lane >> 4;
    const int K = g.K, nt = K / BK;
    unsigned voffA[2], voffB[2];
#pragma unroll
    for (int i = 0; i < 2; ++i) { int R, C; stage_rc(tid * 16 + i * 8192, R, C); const int Rb = Epi::PERM ? ((R & ~31) + perm32(R & 31)) : R;
        voffA[i] = (unsigned)(R * K + C) * 2u; voffB[i] = (unsigned)(Rb * K + C) * 2u; }
    const size_t kstep = (size_t)(BK * 2);
    const size_t hstep = (size_t)HALF * K * 2;
    const size_t tstep = 2 * hstep;
    const unsigned ldsw = (unsigned)wid * 1024u;
    const int aoff = lds_byte(wr * 64 + fr, fq * 8), boff = lds_byte(wc * 32 + fr, fq * 8);
#define PG8_SA(b, h) (((b) * 2 + (h)) * HTB)
#define PG8_SB(b, h) ((4 + (b) * 2 + (h)) * HTB)
#define PG8_STAGE(bufoff, gbase, voff) do { _Pragma("unroll") for (int _i = 0; _i < 2; ++_i) \
        __builtin_amdgcn_global_load_lds((const unsigned*)((const char*)(gbase) + (voff)[_i]), (LAS unsigned*)(lds + (bufoff) + ldsw + _i * 8192), 16, 0, 0); } while (0)
#define PG8_LDA(dst, b, h) do { _Pragma("unroll") for (int m = 0; m < 4; ++m) _Pragma("unroll") for (int k = 0; k < 2; ++k) dst[m][k] = *(const LAS bf16x8*)(lds + PG8_SA(b, h) + aoff + m * 2048 + k * 1024); } while (0)
#define PG8_LDB(dst, b, h) do { _Pragma("unroll") for (int n = 0; n < 2; ++n) _Pragma("unroll") for (int k = 0; k < 2; ++k) dst[n][k] = *(const LAS bf16x8*)(lds + PG8_SB(b, h) + boff + n * 2048 + k * 1024); } while (0)
#define PG8_MMA(ai, bj, At, Bt) do { __builtin_amdgcn_s_setprio(1); _Pragma("unroll") for (int m = 0; m < 4; ++m) _Pragma("unroll") for (int n = 0; n < 2; ++n) _Pragma("unroll") for (int k = 0; k < 2; ++k) \
        acc[ai][bj][m][n] = __builtin_amdgcn_mfma_f32_16x16x32_bf16(Bt[n][k], At[m][k], acc[ai][bj][m][n], 0, 0, 0); __builtin_amdgcn_s_setprio(0); } while (0)
#define PG8_WAIT_V(n) asm volatile("s_waitcnt vmcnt(" #n ")" ::: "memory")
#define PG8_WAIT_L(n) asm volatile("s_waitcnt lgkmcnt(" #n ")" ::: "memory")
#define PG8_BAR __builtin_amdgcn_s_barrier()
#define PG8_SCHED __builtin_amdgcn_sched_barrier(0)
    Unit cur, nxt; int ui = 0;
    if (!S.next(0, cur)) return;
    f32x4 acc[2][2][4][2];
#pragma unroll
    for (int a = 0; a < 2; ++a)
#pragma unroll
        for (int b = 0; b < 2; ++b)
#pragma unroll
            for (int m = 0; m < 4; ++m)
#pragma unroll
                for (int n = 0; n < 2; ++n) acc[a][b][m][n] = (f32x4){0.f, 0.f, 0.f, 0.f};
    bf16x8 At[4][2], B0[2][2], B1[2][2];
    const char* cA = (const char*)g.A + (size_t)cur.pm * tstep; const char* cB = (const char*)g.Bt + (size_t)cur.pn * tstep;
    PG8_STAGE(PG8_SB(0, 0), cB, voffB); PG8_STAGE(PG8_SA(0, 0), cA, voffA); PG8_STAGE(PG8_SB(0, 1), cB + hstep, voffB); PG8_STAGE(PG8_SA(0, 1), cA + hstep, voffA);
    if (wr == 1) PG8_BAR;
    PG8_WAIT_V(4); PG8_BAR;
    PG8_STAGE(PG8_SB(1, 0), cB + kstep, voffB); PG8_STAGE(PG8_SA(1, 0), cA + kstep, voffA); PG8_STAGE(PG8_SB(1, 1), cB + hstep + kstep, voffB);
    PG8_WAIT_V(6); PG8_BAR;
    for (;;) {
        const bool has_next = S.next(ui + 1, nxt);
        const char* nA = has_next ? (const char*)g.A + (size_t)nxt.pm * tstep : cA; const char* nB = has_next ? (const char*)g.Bt + (size_t)nxt.pn * tstep : cB;
        for (int t = 0; t < nt; t += 2) {
            const bool last = (t == nt - 2);
            const char* a1 = cA + (size_t)(t + 1) * kstep;
            const char* a2 = last ? nA : cA + (size_t)(t + 2) * kstep; const char* b2 = last ? nB : cB + (size_t)(t + 2) * kstep;
            const char* a3 = a2 + kstep; const char* b3 = b2 + kstep;
            PG8_LDB(B0, 0, 0); PG8_SCHED; PG8_LDA(At, 0, 0); PG8_STAGE(PG8_SA(1, 1), a1 + hstep, voffA);
            PG8_WAIT_L(8); PG8_BAR; PG8_WAIT_L(0); PG8_MMA(0, 0, At, B0); PG8_BAR; PG8_SCHED;
            PG8_LDB(B1, 0, 1); PG8_STAGE(PG8_SB(0, 0), b2, voffB);
            PG8_BAR; PG8_WAIT_L(0); PG8_MMA(0, 1, At, B1); PG8_BAR;
            PG8_LDA(At, 0, 1); PG8_STAGE(PG8_SA(0, 0), a2, voffA);
            PG8_BAR; PG8_WAIT_L(0); PG8_MMA(1, 0, At, B0); PG8_BAR; PG8_SCHED;
            PG8_STAGE(PG8_SB(0, 1), b2 + hstep, voffB);
            PG8_WAIT_V(6); PG8_BAR; PG8_MMA(1, 1, At, B1); PG8_BAR;
            PG8_LDB(B0, 1, 0); PG8_SCHED; PG8_LDA(At, 1, 0); PG8_STAGE(PG8_SA(0, 1), a2 + hstep, voffA);
            PG8_WAIT_L(8); PG8_BAR; PG8_WAIT_L(0); PG8_MMA(0, 0, At, B0); PG8_BAR; PG8_SCHED;
            PG8_LDB(B1, 1, 1); PG8_STAGE(PG8_SB(1, 0), b3, voffB);
            PG8_BAR; PG8_WAIT_L(0); PG8_MMA(0, 1, At, B1); PG8_BAR;
            PG8_LDA(At, 1, 1); PG8_STAGE(PG8_SA(1, 0), a3, voffA);
            PG8_BAR; PG8_WAIT_L(0); PG8_MMA(1, 0, At, B0); PG8_BAR; PG8_SCHED;
            PG8_STAGE(PG8_SB(1, 1), b3 + hstep, voffB);
            PG8_WAIT_V(6); PG8_BAR; PG8_MMA(1, 1, At, B1); PG8_BAR;
        }
        E(acc, cur, wr, wc, fr, fq);
        if (!has_next) break;
#pragma unroll
        for (int a = 0; a < 2; ++a)
#pragma unroll
            for (int b = 0; b < 2; ++b)
#pragma unroll
                for (int m = 0; m < 4; ++m)
#pragma unroll
                    for (int n = 0; n < 2; ++n) acc[a][b][m][n] = (f32x4){0.f, 0.f, 0.f, 0.f};
        cur = nxt; cA = nA; cB = nB; ++ui;
    }
    PG8_WAIT_V(0);
    if (wr == 0) PG8_BAR;
    PG8_BAR;
#undef PG8_SA
#undef PG8_SB
#undef PG8_STAGE
#undef PG8_LDA
#undef PG8_LDB
#undef PG8_MMA
#undef PG8_WAIT_V
#undef PG8_WAIT_L
#undef PG8_BAR
#undef PG8_SCHED
}

struct EpiF32 {
    static constexpr bool PERM = false;
    float* C; int ldc;
    __device__ __forceinline__ void operator()(const f32x4 (&acc)[2][2][4][2], const Unit& u, int wr, int wc, int fr, int fq) const {
        const int row0 = u.pm * BM + wr * 64 + fr, col0 = u.pn * BM + wc * 32 + 4 * fq;
#pragma unroll
        for (int ai = 0; ai < 2; ++ai)
#pragma unroll
            for (int m = 0; m < 4; ++m) { float* rowp = C + (size_t)(row0 + ai * HALF + m * 16) * ldc + col0;
#pragma unroll
                for (int bj = 0; bj < 2; ++bj)
#pragma unroll
                    for (int n = 0; n < 2; ++n) *(f32x4*)(rowp + bj * HALF + n * 16) = acc[ai][bj][m][n]; }
    }
};
struct EpiBf16 {
    static constexpr bool PERM = true;
    bf16_t* O; int ldc;
    __device__ __forceinline__ void operator()(const f32x4 (&acc)[2][2][4][2], const Unit& u, int wr, int wc, int fr, int fq) const {
        const int row0 = u.pm * BM + wr * 64 + fr, col0 = u.pn * BM + wc * 32 + 8 * fq;
#pragma unroll
        for (int ai = 0; ai < 2; ++ai)
#pragma unroll
            for (int m = 0; m < 4; ++m) { bf16_t* rowp = O + (size_t)(row0 + ai * HALF + m * 16) * ldc + col0;
#pragma unroll
                for (int bj = 0; bj < 2; ++bj) { const f32x4 v0 = acc[ai][bj][m][0], v1 = acc[ai][bj][m][1];
                    u32x4 o; o.x = pk2(v0[0], v0[1]); o.y = pk2(v0[2], v0[3]); o.z = pk2(v1[0], v1[1]); o.w = pk2(v1[2], v1[3]);
                    *(u32x4*)(rowp + bj * HALF) = o; } }
    }
};
struct EpiSwiGLU {
    static constexpr bool PERM = true;
    bf16_t* O; int ldc;
    __device__ __forceinline__ void operator()(const f32x4 (&acc)[2][2][4][2], const Unit& u, int wr, int wc, int fr, int fq) const {
        const int row0 = u.pm * BM + wr * 64 + fr, col0 = u.pn * HALF + wc * 32 + 8 * fq;
#pragma unroll
        for (int ai = 0; ai < 2; ++ai)
#pragma unroll
            for (int m = 0; m < 4; ++m) { bf16_t* rowp = O + (size_t)(row0 + ai * HALF + m * 16) * ldc + col0;
                float v[8];
#pragma unroll
                for (int n = 0; n < 2; ++n)
#pragma unroll
                    for (int i = 0; i < 4; ++i) { const float gt = acc[ai][0][m][n][i], up = acc[ai][1][m][n][i]; v[n * 4 + i] = gt * sigmoidf_(gt) * up; }
                u32x4 o; o.x = pk2(v[0], v[1]); o.y = pk2(v[2], v[3]); o.z = pk2(v[4], v[5]); o.w = pk2(v[6], v[7]);
                *(u32x4*)rowp = o; }
    }
};
}

__device__ __forceinline__ void transpose_item(const float* __restrict__ W, int ldw, int ncols, int c0, int k0, bf16_t* dst, int ldd, LAS float* scr, int lane) {
    float tv[32]; const int cc = c0 + (lane & 31); const float* wp = W + (size_t)(k0 + (lane >> 5)) * ldw + cc;
#pragma unroll
    for (int i = 0; i < 32; ++i) tv[i] = (cc < ncols) ? wp[(size_t)(2 * i) * ldw] : 0.f;
#pragma unroll
    for (int i = 0; i < 32; ++i) scr[(2 * i + (lane >> 5)) * 33 + (lane & 31)] = tv[i];
    LDS_WAIT();
    const int c = lane & 7;
#pragma unroll
    for (int j = 0; j < 4; ++j) { const int n = (lane >> 3) + 8 * j; const LAS float* s = scr + (8 * c) * 33 + n;
        u32x4 o; o.x = pk2(s[0 * 33], s[1 * 33]); o.y = pk2(s[2 * 33], s[3 * 33]); o.z = pk2(s[4 * 33], s[5 * 33]); o.w = pk2(s[6 * 33], s[7 * 33]);
        *(u32x4*)(dst + (size_t)n * ldd + k0 + 8 * c) = o; }
    LDS_WAIT();
}
__device__ __forceinline__ void conv_plain(const float* W, int K, int N, int Npad, bf16_t* dst, LAS float* scr, int lane, int gw, int NGW) {
    const int nblk = Npad / 32, items = (K / 64) * nblk;
    for (int it = gw; it < items; it += NGW) { const int kb = it / nblk, nb = it % nblk;
        transpose_item(W, N, N, nb * 32, kb * 64, dst + (size_t)nb * 32 * K, K, scr, lane); }
}
__device__ __forceinline__ void conv_gateup(const float* Wg, const float* Wu, bf16_t* dst, LAS float* scr, int lane, int gw, int NGW) {
    const int nblk = (2 * FF_) / 32, items = (D_ / 64) * nblk;
    for (int it = gw; it < items; it += NGW) { const int kb = it / nblk, nb = it % nblk; const int n0 = nb * 32, tile = n0 >> 8, w = n0 & 255;
        const float* W = (w < 128) ? Wg : Wu; const int c0 = tile * 128 + (w & 127);
        transpose_item(W, FF_, FF_, c0, kb * 64, dst + (size_t)n0 * D_, D_, scr, lane); }
}
__device__ __forceinline__ void rms_row_to_bf16(const float* xrow, const float* g, bf16_t* orow, int lane) {
    const f32x4* xr = (const f32x4*)xrow + lane; const f32x4* gr = (const f32x4*)g + lane;
    f32x4 v[8]; float s = 0.f;
#pragma unroll
    for (int j = 0; j < 8; ++j) { v[j] = xr[64 * j]; s += (v[j].x * v[j].x + v[j].y * v[j].y) + (v[j].z * v[j].z + v[j].w * v[j].w); }
    const float rs = rsqrtf(wave_sum(s) * (1.f / D_) + EPS_);
    u32x2* o8 = (u32x2*)orow + lane;
#pragma unroll
    for (int j = 0; j < 8; ++j) { const f32x4 gg = gr[64 * j]; u32x2 o; o.x = pk2(v[j].x * rs * gg.x, v[j].y * rs * gg.y); o.y = pk2(v[j].z * rs * gg.z, v[j].w * rs * gg.w); o8[64 * j] = o; }
}
__device__ __forceinline__ void norm_phase(const float* hin, const bf16_t* Y, float coef, const float* g_post, float* hout, const float* g_pre, bf16_t* xn, int lane, int gw, int NGW) {
    for (int row = gw; row < S_; row += NGW) {
        const u32x2* yr = (const u32x2*)(Y + (size_t)row * D_) + lane; const f32x4* hr = (const f32x4*)(hin + (size_t)row * D_) + lane;
        const f32x4* gp = (const f32x4*)g_post + lane;
        f32x4 v[8]; float s = 0.f;
#pragma unroll
        for (int j = 0; j < 8; ++j) { const u32x2 w = yr[64 * j]; v[j].x = __uint_as_float(w.x << 16); v[j].y = __uint_as_float(w.x & 0xffff0000u); v[j].z = __uint_as_float(w.y << 16); v[j].w = __uint_as_float(w.y & 0xffff0000u);
            s += (v[j].x * v[j].x + v[j].y * v[j].y) + (v[j].z * v[j].z + v[j].w * v[j].w); }
        const float rs = rsqrtf(wave_sum(s) * (1.f / D_) + EPS_) * coef;
        f32x4* ho = (f32x4*)(hout + (size_t)row * D_) + lane;
        float s2 = 0.f;
#pragma unroll
        for (int j = 0; j < 8; ++j) { const f32x4 gg = gp[64 * j]; const f32x4 h = hr[64 * j];
            v[j].x = h.x + v[j].x * rs * gg.x; v[j].y = h.y + v[j].y * rs * gg.y; v[j].z = h.z + v[j].z * rs * gg.z; v[j].w = h.w + v[j].w * rs * gg.w;
            ho[64 * j] = v[j]; s2 += (v[j].x * v[j].x + v[j].y * v[j].y) + (v[j].z * v[j].z + v[j].w * v[j].w); }
        if (g_pre) {
            const float rs2 = rsqrtf(wave_sum(s2) * (1.f / D_) + EPS_);
            const f32x4* gq = (const f32x4*)g_pre + lane; u32x2* o8 = (u32x2*)(xn + (size_t)row * D_) + lane;
#pragma unroll
            for (int j = 0; j < 8; ++j) { const f32x4 gg = gq[64 * j]; u32x2 o; o.x = pk2(v[j].x * rs2 * gg.x, v[j].y * rs2 * gg.y); o.y = pk2(v[j].z * rs2 * gg.z, v[j].w * rs2 * gg.w); o8[64 * j] = o; }
        }
    }
}

__device__ __forceinline__ f32x4 wave_tile_gemm(const bf16_t* A, int lda, const bf16_t* Bt, int ldb, int K, int lane) {
    const bf16_t* ap = A + (size_t)(lane & 15) * lda + (lane >> 4) * 8; const bf16_t* bp = Bt + (size_t)(lane & 15) * ldb + (lane >> 4) * 8;
    f32x4 acc = {0.f, 0.f, 0.f, 0.f};
#pragma unroll 4
    for (int k = 0; k < K; k += 32) { const bf16x8 a = *(const bf16x8*)(ap + k), b = *(const bf16x8*)(bp + k); acc = __builtin_amdgcn_mfma_f32_16x16x32_bf16(a, b, acc, 0, 0, 0); }
    return acc;
}


__device__ __forceinline__ float tanhf_(float x) { const float e = __expf(2.f * x); return 1.f - 2.f * __builtin_amdgcn_rcpf(e + 1.f); }
__device__ __forceinline__ float gelu_tanh(float x) { return 0.5f * x * (1.f + tanhf_(0.7978845608f * (x + 0.044715f * x * x * x))); }
__device__ __forceinline__ bf16x8 pack8(const f32x4 a, const f32x4 b) { u32x4 o; o.x = pk2(a[0], a[1]); o.y = pk2(a[2], a[3]); o.z = pk2(b[0], b[1]); o.w = pk2(b[2], b[3]); return __builtin_bit_cast(bf16x8, o); }
__device__ __forceinline__ bf16x8 ld2x4(const bf16_t* p0, const bf16_t* p1) { const u32x2 a = *(const u32x2*)p0, b = *(const u32x2*)p1; u32x4 o; o.x = a.x; o.y = a.y; o.z = b.x; o.w = b.y; return __builtin_bit_cast(bf16x8, o); }
__device__ __forceinline__ float shiftv(const bf16_t* F, int t, int col, float mu) { const float f = bf2f(F[(size_t)t * IN_PAD + col]); const float fp = t > 0 ? bf2f(F[(size_t)(t - 1) * IN_PAD + col]) : 0.f; return f + mu * (fp - f); }

constexpr int C_R = 0, C_K = 1024, C_V = 2048, C_WD = 3072, C_Q = 3360, C_KC = 4384, C_VC = 4640, C_KS = 4896, C_VS = 5152, C_KW = 5408, C_VW = 5664, C_GL = 5920;

struct EpiLora {
    static constexpr bool PERM = true;
    bf16_t* O; const float* w0; const float* a0;
    __device__ __forceinline__ void operator()(const f32x4 (&acc)[2][2][4][2], const pg8::Unit& u, int wr, int wc, int fr, int fq) const {
        { int ln; asm volatile("v_mbcnt_lo_u32_b32 %0, -1, 0\n\tv_mbcnt_hi_u32_b32 %0, -1, %0" : "=v"(ln)); fr = ln & 15; fq = ln >> 4; }
        const int row0 = u.pm * 256 + wr * 64 + fr, col0 = u.pn * 256 + wc * 32 + 8 * fq; const int type = u.pn >> 2;
#pragma unroll
        for (int ai = 0; ai < 2; ++ai)
#pragma unroll
            for (int m = 0; m < 4; ++m) { bf16_t* rowp = O + (size_t)(row0 + ai * 128 + m * 16) * LORA_N + col0;
#pragma unroll
                for (int bj = 0; bj < 2; ++bj) { float v[8];
#pragma unroll
                    for (int n = 0; n < 2; ++n)
#pragma unroll
                        for (int i = 0; i < 4; ++i) { float x = acc[ai][bj][m][n][i]; const int c = (col0 + bj * 128 + n * 4 + i) & 1023;
                            if (type == 0) x = 0.60653066f * sigmoidf_(x + w0[c]); else if (type == 1) x = sigmoidf_(x + a0[c]);
                            v[n * 4 + i] = x; }
                    u32x4 o; o.x = pk2(v[0], v[1]); o.y = pk2(v[2], v[3]); o.z = pk2(v[4], v[5]); o.w = pk2(v[6], v[7]);
                    *(u32x4*)(rowp + bj * 128) = o; } }
    }
};

__device__ __forceinline__ void compress_task(const Params& p, unsigned char* ws, int task, int lane) {
    const int which = task >> 8, g = (task >> 6) & 3, n0 = (task & 63) * 16;
    const bf16_t* FE = (const bf16_t*)(ws + OFF_ACT);
    const bf16_t* W1T = (const bf16_t*)(ws + (which ? OFF_WC1V : OFF_WC1K));
    const bf16_t* W2T = (const bf16_t*)(ws + (which ? OFF_WC2V : OFF_WC2K));
    const float* pe = which ? p.in[23] : p.in[20];
    const int cb = (which ? C_VC : C_KC) + g * 64;
    const int col = lane & 15, quad = lane >> 4;
    int nn = n0 + col; if (nn > 1022) nn = 1022;
    f32x4 acc[8];
#pragma unroll
    for (int i = 0; i < 8; ++i) acc[i] = (f32x4){0.f, 0.f, 0.f, 0.f};
    for (int kt = 0; kt < 64; ++kt) {
        const int pp = kt >> 1, d = (kt & 1) * 32 + quad * 8;
        const bf16x8 xf = *(const bf16x8*)(FE + (size_t)(16 * nn + pp) * IN_PAD + cb + d);
        const f32x4 pa = *(const f32x4*)(pe + pp * 64 + d), pb = *(const f32x4*)(pe + pp * 64 + d + 4);
        const bf16x8 pf = pack8(pa, pb);
#pragma unroll
        for (int ct = 0; ct < 8; ++ct) { const bf16x8 wf = *(const bf16x8*)(W1T + (size_t)(ct * 16 + col) * 2048 + kt * 32 + quad * 8);
            acc[ct] = __builtin_amdgcn_mfma_f32_16x16x32_bf16(wf, xf, acc[ct], 0, 0, 0);
            acc[ct] = __builtin_amdgcn_mfma_f32_16x16x32_bf16(wf, pf, acc[ct], 0, 0, 0); }
    }
#pragma unroll
    for (int ct = 0; ct < 8; ++ct)
#pragma unroll
        for (int r = 0; r < 4; ++r) acc[ct][r] = gelu_tanh(acc[ct][r]);
    f32x4 o[4];
#pragma unroll
    for (int et = 0; et < 4; ++et) { o[et] = (f32x4){0.f, 0.f, 0.f, 0.f};
#pragma unroll
        for (int i = 0; i < 4; ++i) { const bf16x8 hf = pack8(acc[2 * i], acc[2 * i + 1]);
            const bf16_t* wr_ = W2T + (size_t)(et * 16 + col) * 128 + 32 * i + quad * 4;
            const bf16x8 wf = ld2x4(wr_, wr_ + 16);
            o[et] = __builtin_amdgcn_mfma_f32_16x16x32_bf16(wf, hf, o[et], 0, 0, 0); } }
    const int n = n0 + col;
    if (which == 0) { bf16_t* K = (bf16_t*)(ws + OFF_KCMP) + ((size_t)g * 64 + (n >> 4)) * 1024 + (n & 15) * 32;
#pragma unroll
        for (int et = 0; et < 4; ++et) { u32x2 v; v.x = pk2(o[et][0], o[et][1]); v.y = pk2(o[et][2], o[et][3]); *(u32x2*)(K + (et >> 1) * 512 + (et & 1) * 16 + quad * 4) = v; }
    } else { bf16_t* V = (bf16_t*)(ws + OFF_VCMPT) + ((size_t)g * 32 + (n >> 5)) * 2048 + ((n & 15) >> 2) * 8 + ((n >> 4) & 1) * 4 + (n & 3);
#pragma unroll
        for (int et = 0; et < 4; ++et)
#pragma unroll
            for (int r = 0; r < 4; ++r) V[et * 512 + (quad * 4 + r) * 32] = f2bf(o[et][r]);
    }
}

constexpr int SCAN_T = 32, SCAN_BUF_F = 5 * SCAN_T * 64 + SCAN_T * 16;
struct ScanRaw { float rr[9], kr[9], vr[9], uu[8], aa[8], nrm[8]; };
__device__ __forceinline__ void scan_fetch(ScanRaw& x, unsigned char* ws, int c, int head, int rbase, int lw, int lane) {
    const bf16_t* FE = (const bf16_t*)(ws + OFF_ACT); const bf16_t* LO = (const bf16_t*)(ws + OFF_LORA);
    const int cr = head * 64 + lane, vcol = C_V + head * 64 + rbase + (lane & 15), ta = c * SCAN_T + lw * 8;
#pragma unroll
    for (int i = 0; i < 9; ++i) { const int t = ta - 1 + i;
        if (t >= 0) { x.rr[i] = bf2f(FE[(size_t)t * IN_PAD + C_R + cr]); x.kr[i] = bf2f(FE[(size_t)t * IN_PAD + C_K + cr]); x.vr[i] = bf2f(FE[(size_t)t * IN_PAD + vcol]); }
        else { x.rr[i] = 0.f; x.kr[i] = 0.f; x.vr[i] = 0.f; } }
#pragma unroll
    for (int i = 0; i < 8; ++i) { const int t = ta + i; x.uu[i] = bf2f(LO[(size_t)t * LORA_N + cr]); x.aa[i] = bf2f(LO[(size_t)t * LORA_N + 1024 + cr]); x.nrm[i] = ((const float*)(ws + OFF_KN2))[t * 16 + head]; }
}
__device__ __forceinline__ void scan_emit(const ScanRaw& x, LAS float* buf, float mu_r, float mu_k, float mu_v, float kkw, float kaw, int lw, int lane) {
#pragma unroll
    for (int i = 0; i < 8; ++i) { const int tt = lw * 8 + i;
        const float r = x.rr[i + 1] + mu_r * (x.rr[i] - x.rr[i + 1]), k = x.kr[i + 1] + mu_k * (x.kr[i] - x.kr[i + 1]), v = x.vr[i + 1] + mu_v * (x.vr[i] - x.vr[i + 1]);
        const float a = x.aa[i], w = __expf(-x.uu[i]);
        const float kkn = k * kkw * x.nrm[i];
        buf[0 * SCAN_T * 64 + tt * 64 + lane] = w;
        buf[1 * SCAN_T * 64 + tt * 64 + lane] = -kkn;
        buf[2 * SCAN_T * 64 + tt * 64 + lane] = kkn * a;
        buf[3 * SCAN_T * 64 + tt * 64 + lane] = k * (1.f + (a - 1.f) * kaw);
        buf[4 * SCAN_T * 64 + tt * 64 + lane] = r;
        if (lane < 16) buf[5 * SCAN_T * 64 + tt * 16 + lane] = v; }
}
__device__ __forceinline__ void scan_step(float& s0, float& s1, float& s2, float& s3, const f32x4 NK, const f32x4 W, const f32x4 B, const f32x4 R,
                                          float t0, float t1, float t2, float t3, float& yp, float& yc) {
    float sa, tmp;
    asm volatile(
        "v_mul_f32 %[sa], %[s0], %[n0]\n\t"
        "v_mul_f32 %[tmp], %[s2], %[n2]\n\t"
        "v_fmac_f32 %[sa], %[s1], %[n1]\n\t"
        "v_fmac_f32 %[tmp], %[s3], %[n3]\n\t"
        "v_add_f32 %[sa], %[sa], %[tmp]\n\t"
        "s_nop 1\n\t"
        "v_add_f32_dpp %[sa], %[sa], %[sa] row_ror:8 row_mask:0xf bank_mask:0xf\n\t"
        "v_add_f32_dpp %[yp], %[yp], %[yp] row_ror:8 row_mask:0xf bank_mask:0xf\n\t"
        "s_nop 0\n\t"
        "v_add_f32_dpp %[sa], %[sa], %[sa] row_ror:4 row_mask:0xf bank_mask:0xf\n\t"
        "v_add_f32_dpp %[yp], %[yp], %[yp] row_ror:4 row_mask:0xf bank_mask:0xf\n\t"
        "s_nop 0\n\t"
        "v_add_f32_dpp %[sa], %[sa], %[sa] row_ror:2 row_mask:0xf bank_mask:0xf\n\t"
        "v_add_f32_dpp %[yp], %[yp], %[yp] row_ror:2 row_mask:0xf bank_mask:0xf\n\t"
        "s_nop 0\n\t"
        "v_add_f32_dpp %[sa], %[sa], %[sa] row_ror:1 row_mask:0xf bank_mask:0xf\n\t"
        "v_add_f32_dpp %[yp], %[yp], %[yp] row_ror:1 row_mask:0xf bank_mask:0xf\n\t"
        "v_fmac_f32 %[t0], %[sa], %[b0]\n\t"
        "v_fmac_f32 %[t1], %[sa], %[b1]\n\t"
        "v_fmac_f32 %[t2], %[sa], %[b2]\n\t"
        "v_fmac_f32 %[t3], %[sa], %[b3]\n\t"
        "v_fma_f32 %[s0], %[s0], %[w0], %[t0]\n\t"
        "v_fma_f32 %[s1], %[s1], %[w1], %[t1]\n\t"
        "v_fma_f32 %[s2], %[s2], %[w2], %[t2]\n\t"
        "v_fma_f32 %[s3], %[s3], %[w3], %[t3]\n\t"
        "v_mul_f32 %[yc], %[s0], %[r0]\n\t"
        "v_mul_f32 %[tmp], %[s2], %[r2]\n\t"
        "v_fmac_f32 %[yc], %[s1], %[r1]\n\t"
        "v_fmac_f32 %[tmp], %[s3], %[r3]\n\t"
        "v_add_f32 %[yc], %[yc], %[tmp]\n\t"
        : [s0] "+v"(s0), [s1] "+v"(s1), [s2] "+v"(s2), [s3] "+v"(s3), [t0] "+v"(t0), [t1] "+v"(t1), [t2] "+v"(t2), [t3] "+v"(t3),
          [yp] "+v"(yp), [yc] "=&v"(yc), [sa] "=&v"(sa), [tmp] "=&v"(tmp)
        : [n0] "v"(NK.x), [n1] "v"(NK.y), [n2] "v"(NK.z), [n3] "v"(NK.w), [w0] "v"(W.x), [w1] "v"(W.y), [w2] "v"(W.z), [w3] "v"(W.w),
          [b0] "v"(B.x), [b1] "v"(B.y), [b2] "v"(B.z), [b3] "v"(B.w), [r0] "v"(R.x), [r1] "v"(R.y), [r2] "v"(R.z), [r3] "v"(R.w));
}
__device__ __forceinline__ f32x2 scan_dot2(const f32x2 sA, const f32x2 sB, const f32x2 xA, const f32x2 xB) {
    f32x2 t;
    asm volatile("v_pk_mul_f32 %[t], %[sA], %[xA]\n\tv_pk_fma_f32 %[t], %[sB], %[xB], %[t]\n\t" : [t] "=&v"(t) : [sA] "v"(sA), [sB] "v"(sB), [xA] "v"(xA), [xB] "v"(xB));
    return t;
}
__device__ __forceinline__ void scan_reduce2(float& sa, float& yp) {
    asm volatile(
        "s_nop 1\n\t"
        "v_add_f32_dpp %[sa], %[sa], %[sa] row_ror:8 row_mask:0xf bank_mask:0xf\n\t"
        "v_add_f32_dpp %[yp], %[yp], %[yp] row_ror:8 row_mask:0xf bank_mask:0xf\n\t"
        "s_nop 0\n\t"
        "v_add_f32_dpp %[sa], %[sa], %[sa] row_ror:4 row_mask:0xf bank_mask:0xf\n\t"
        "v_add_f32_dpp %[yp], %[yp], %[yp] row_ror:4 row_mask:0xf bank_mask:0xf\n\t"
        "s_nop 0\n\t"
        "v_add_f32_dpp %[sa], %[sa], %[sa] row_ror:2 row_mask:0xf bank_mask:0xf\n\t"
        "v_add_f32_dpp %[yp], %[yp], %[yp] row_ror:2 row_mask:0xf bank_mask:0xf\n\t"
        "s_nop 0\n\t"
        "v_add_f32_dpp %[sa], %[sa], %[sa] row_ror:1 row_mask:0xf bank_mask:0xf\n\t"
        "v_add_f32_dpp %[yp], %[yp], %[yp] row_ror:1 row_mask:0xf bank_mask:0xf\n\t"
        "s_nop 1\n\t"
        : [sa] "+v"(sa), [yp] "+v"(yp));
}
__device__ __forceinline__ void scan_update2(f32x2& sA, f32x2& sB, const f32x2 wA, const f32x2 wB, const f32x2 bA, const f32x2 bB, const f32x2 kA, const f32x2 kB, const f32x2 sa2, const f32x2 vv2) {
    f32x2 uA, uB;
    asm volatile(
        "v_pk_mul_f32 %[uA], %[kA], %[vv2] op_sel_hi:[1,0]\n\t"
        "v_pk_mul_f32 %[uB], %[kB], %[vv2] op_sel_hi:[1,0]\n\t"
        "v_pk_fma_f32 %[uA], %[bA], %[sa2], %[uA] op_sel_hi:[1,0,1]\n\t"
        "v_pk_fma_f32 %[uB], %[bB], %[sa2], %[uB] op_sel_hi:[1,0,1]\n\t"
        "v_pk_fma_f32 %[sA], %[sA], %[wA], %[uA]\n\t"
        "v_pk_fma_f32 %[sB], %[sB], %[wB], %[uB]\n\t"
        : [sA] "+v"(sA), [sB] "+v"(sB), [uA] "=&v"(uA), [uB] "=&v"(uB)
        : [wA] "v"(wA), [wB] "v"(wB), [bA] "v"(bA), [bB] "v"(bB), [kA] "v"(kA), [kB] "v"(kB), [sa2] "v"(sa2), [vv2] "v"(vv2));
}
#define SCAN_BAR() do { asm volatile("s_waitcnt lgkmcnt(0)" ::: "memory"); __builtin_amdgcn_s_barrier(); asm volatile("" ::: "memory"); } while (0)
__device__ __forceinline__ void rwkv_scan_block(const Params& p, unsigned char* ws, LAS unsigned char* lds, int sb, int tid) {
    const int lane = tid & 63, wave = tid >> 6; const int head = sb >> 2, rbase = (sb & 3) * 16;
    LAS float* buf0 = (LAS float*)lds; LAS float* buf1 = buf0 + SCAN_BUF_F;
    bf16_t* YR = (bf16_t*)(ws + OFF_YRAW);
    const int cg_ = lane & 15, rl = (wave & 3) * 4 + (lane >> 4);
    constexpr int NCH = S_ / SCAN_T;
    if (wave >= 4) {
        const int lw = wave - 4; const int cr = head * 64 + lane, vcol = C_V + head * 64 + rbase + (lane & 15);
        const float mu_r = p.in[9][C_R + cr], mu_k = p.in[9][C_K + cr], mu_v = p.in[9][vcol], kkw = p.in[15][cr], kaw = p.in[16][cr];
        ScanRaw x; scan_fetch(x, ws, 0, head, rbase, lw, lane); scan_emit(x, buf0, mu_r, mu_k, mu_v, kkw, kaw, lw, lane); scan_fetch(x, ws, 1, head, rbase, lw, lane);
        SCAN_BAR();
        for (int c = 0; c < NCH; ++c) {
            if (c + 1 < NCH) scan_emit(x, (c & 1) ? buf0 : buf1, mu_r, mu_k, mu_v, kkw, kaw, lw, lane);
            if (c + 2 < NCH) scan_fetch(x, ws, c + 2, head, rbase, lw, lane);
            SCAN_BAR(); }
    } else {
        f32x2 sA = {0.f, 0.f}, sB = {0.f, 0.f};
        SCAN_BAR();
        for (int c = 0; c < NCH; ++c) {
            LAS float* cb = ((c & 1) ? buf1 : buf0) + cg_ * 4; LAS float* vb = ((c & 1) ? buf1 : buf0) + 5 * SCAN_T * 64 + rl;
#pragma unroll
            for (int hh = 0; hh < SCAN_T / 16; ++hh) {
                float ykeep = 0.f, yp = 0.f, yc = 0.f;
                f32x4 W = *(const LAS f32x4*)(cb + 0 * SCAN_T * 64 + hh * 1024), NK = *(const LAS f32x4*)(cb + 1 * SCAN_T * 64 + hh * 1024), B = *(const LAS f32x4*)(cb + 2 * SCAN_T * 64 + hh * 1024),
                      KP = *(const LAS f32x4*)(cb + 3 * SCAN_T * 64 + hh * 1024), R = *(const LAS f32x4*)(cb + 4 * SCAN_T * 64 + hh * 1024); float vv = vb[hh * 256];
#pragma unroll
                for (int ti = 0; ti < 16; ++ti) {
                    const int tn = hh * 16 + (ti < 15 ? ti + 1 : ti);
                    const f32x4 Wn = *(const LAS f32x4*)(cb + 0 * SCAN_T * 64 + tn * 64), NKn = *(const LAS f32x4*)(cb + 1 * SCAN_T * 64 + tn * 64), Bn = *(const LAS f32x4*)(cb + 2 * SCAN_T * 64 + tn * 64),
                                KPn = *(const LAS f32x4*)(cb + 3 * SCAN_T * 64 + tn * 64), Rn = *(const LAS f32x4*)(cb + 4 * SCAN_T * 64 + tn * 64); const float vn = vb[tn * 16];
                    const f32x2 d = scan_dot2(sA, sB, (f32x2){NK.x, NK.y}, (f32x2){NK.z, NK.w});
                    float sa = d.x + d.y; yp = yc;
                    scan_reduce2(sa, yp);
                    f32x2 sa2; sa2.x = sa; sa2.y = sa; f32x2 vv2; vv2.x = vv; vv2.y = vv;
                    scan_update2(sA, sB, (f32x2){W.x, W.y}, (f32x2){W.z, W.w}, (f32x2){B.x, B.y}, (f32x2){B.z, B.w}, (f32x2){KP.x, KP.y}, (f32x2){KP.z, KP.w}, sa2, vv2);
                    const f32x2 e = scan_dot2(sA, sB, (f32x2){R.x, R.y}, (f32x2){R.z, R.w});
                    yc = e.x + e.y;
                    if (ti >= 1) ykeep = (cg_ == ti - 1) ? yp : ykeep;
                    W = Wn; NK = NKn; B = Bn; KP = KPn; R = Rn; vv = vn;
                }
                const float y15 = rowsum16(yc);
                ykeep = (cg_ == 15) ? y15 : ykeep;
                YR[(size_t)(c * SCAN_T + hh * 16 + cg_) * 1024 + head * 64 + rbase + rl] = f2bf(ykeep);
            }
            SCAN_BAR(); }
    }
}

constexpr float QK_SCALE2 = 0.125f * 1.4426950408889634f;
struct Flash { float m, l; f32x4 o[4]; };
__device__ __forceinline__ void flash_init(Flash& f) { f.m = -1e30f; f.l = 0.f;
#pragma unroll
    for (int i = 0; i < 4; ++i) f.o[i] = (f32x4){0.f, 0.f, 0.f, 0.f}; }
struct KV64 { bf16x8 k[4][2]; bf16x8 v[2][4]; };
__device__ __forceinline__ void load_kv64(KV64& x, const bf16_t* Kp, const bf16_t* Vt, int kb, int col, int quad) {
#pragma unroll
    for (int a = 0; a < 4; ++a) { const bf16_t* kr = Kp + (size_t)((kb >> 4) + a) * 1024 + col * 32 + quad * 8; x.k[a][0] = *(const bf16x8*)kr; x.k[a][1] = *(const bf16x8*)(kr + 512); }
#pragma unroll
    for (int h = 0; h < 2; ++h)
#pragma unroll
        for (int dt = 0; dt < 4; ++dt) { const bf16_t* vr = Vt + (size_t)((kb >> 5) + h) * 2048 + dt * 512 + col * 32 + quad * 8; x.v[h][dt] = *(const bf16x8*)vr; }
}
__device__ __forceinline__ void flash_block64(Flash& f, const bf16x8 (&q)[2], const KV64& x, int kb, int lo, int hi, bool masked, int quad) {
    f32x4 s[4];
#pragma unroll
    for (int a = 0; a < 4; ++a) { s[a] = (f32x4){0.f, 0.f, 0.f, 0.f};
#pragma unroll
        for (int ks = 0; ks < 2; ++ks) s[a] = __builtin_amdgcn_mfma_f32_16x16x32_bf16(x.k[a][ks], q[ks], s[a], 0, 0, 0); }
    if (masked) {
#pragma unroll
        for (int a = 0; a < 4; ++a)
#pragma unroll
            for (int r = 0; r < 4; ++r) { const int key = kb + 16 * a + quad * 4 + r; s[a][r] = (key >= lo && key <= hi) ? s[a][r] : -1e30f; }
    }
    float mx = fmaxf(fmaxf(fmaxf(s[0][0], s[0][1]), fmaxf(s[0][2], s[0][3])), fmaxf(fmaxf(s[1][0], s[1][1]), fmaxf(s[1][2], s[1][3])));
    mx = fmaxf(mx, fmaxf(fmaxf(fmaxf(s[2][0], s[2][1]), fmaxf(s[2][2], s[2][3])), fmaxf(fmaxf(s[3][0], s[3][1]), fmaxf(s[3][2], s[3][3]))));
    mx = quad_allmax(mx) * QK_SCALE2;
    const float mn = fmaxf(f.m, mx);
    if (__ballot(mn != f.m) != 0ull) {
        const float alpha = __builtin_amdgcn_exp2f(f.m - mn); f.m = mn; f.l *= alpha;
#pragma unroll
        for (int dt = 0; dt < 4; ++dt) f.o[dt] *= alpha; }
    float ps = 0.f;
    if (masked) {
#pragma unroll
        for (int a = 0; a < 4; ++a)
#pragma unroll
            for (int r = 0; r < 4; ++r) { const float pv = s[a][r] > -1e29f ? __builtin_amdgcn_exp2f(__builtin_fmaf(s[a][r], QK_SCALE2, -mn)) : 0.f; s[a][r] = pv; ps += pv; }
    } else {
#pragma unroll
        for (int a = 0; a < 4; ++a)
#pragma unroll
            for (int r = 0; r < 4; ++r) { const float pv = __builtin_amdgcn_exp2f(__builtin_fmaf(s[a][r], QK_SCALE2, -mn)); s[a][r] = pv; ps += pv; }
    }
    f.l += ps;
    const bf16x8 p0 = pack8(s[0], s[1]), p1 = pack8(s[2], s[3]);
#pragma unroll
    for (int dt = 0; dt < 4; ++dt) { f.o[dt] = __builtin_amdgcn_mfma_f32_16x16x32_bf16(x.v[0][dt], p0, f.o[dt], 0, 0, 0); f.o[dt] = __builtin_amdgcn_mfma_f32_16x16x32_bf16(x.v[1][dt], p1, f.o[dt], 0, 0, 0); }
}
__device__ __forceinline__ void flash_block64v(Flash& f, const bf16x8 (&q)[2], const KV64& x, bool valid) {
    f32x4 s[4];
#pragma unroll
    for (int a = 0; a < 4; ++a) { s[a] = (f32x4){0.f, 0.f, 0.f, 0.f};
#pragma unroll
        for (int ks = 0; ks < 2; ++ks) s[a] = __builtin_amdgcn_mfma_f32_16x16x32_bf16(x.k[a][ks], q[ks], s[a], 0, 0, 0); }
    float mx = fmaxf(fmaxf(fmaxf(s[0][0], s[0][1]), fmaxf(s[0][2], s[0][3])), fmaxf(fmaxf(s[1][0], s[1][1]), fmaxf(s[1][2], s[1][3])));
    mx = fmaxf(mx, fmaxf(fmaxf(fmaxf(s[2][0], s[2][1]), fmaxf(s[2][2], s[2][3])), fmaxf(fmaxf(s[3][0], s[3][1]), fmaxf(s[3][2], s[3][3]))));
    mx = valid ? quad_allmax(mx) * QK_SCALE2 : f.m;
    const float mn = fmaxf(f.m, mx);
    if (__ballot(mn != f.m) != 0ull) {
        const float alpha = __builtin_amdgcn_exp2f(f.m - mn); f.m = mn; f.l *= alpha;
#pragma unroll
        for (int dt = 0; dt < 4; ++dt) f.o[dt] *= alpha; }
    float ps = 0.f;
#pragma unroll
    for (int a = 0; a < 4; ++a)
#pragma unroll
        for (int r = 0; r < 4; ++r) { const float pv = __builtin_amdgcn_exp2f(__builtin_fmaf(s[a][r], QK_SCALE2, -mn)); s[a][r] = pv; ps += pv; }
    f.l += valid ? ps : 0.f;
    const unsigned vm = valid ? 0xffffffffu : 0u;
    u32x4 p0 = __builtin_bit_cast(u32x4, pack8(s[0], s[1])), p1 = __builtin_bit_cast(u32x4, pack8(s[2], s[3]));
    p0.x &= vm; p0.y &= vm; p0.z &= vm; p0.w &= vm; p1.x &= vm; p1.y &= vm; p1.z &= vm; p1.w &= vm;
    const bf16x8 b0 = __builtin_bit_cast(bf16x8, p0), b1 = __builtin_bit_cast(bf16x8, p1);
#pragma unroll
    for (int dt = 0; dt < 4; ++dt) { f.o[dt] = __builtin_amdgcn_mfma_f32_16x16x32_bf16(x.v[0][dt], b0, f.o[dt], 0, 0, 0); f.o[dt] = __builtin_amdgcn_mfma_f32_16x16x32_bf16(x.v[1][dt], b1, f.o[dt], 0, 0, 0); }
}
__device__ __forceinline__ float flash_finish(const Flash& f) { const float l = quad_allsum(f.l); return l > 0.f ? 1.f / l : 0.f; }

constexpr int NSA_WLDS = 10240;

__device__ __forceinline__ void nsa_q(const bf16_t* FE, const float* ROPE, int tcol, int head, int quad, bf16x8 (&qn)[2], bf16x8 (&qr)[2]) {
    const bf16_t* qrow = FE + (size_t)tcol * IN_PAD + C_Q + head * 64;
    qn[0] = *(const bf16x8*)(qrow + quad * 8); qn[1] = *(const bf16x8*)(qrow + 32 + quad * 8);
    qr[0] = qn[0]; qr[1] = qn[1];
    if (quad < 2) { const bf16x8 ot = *(const bf16x8*)(qrow + (quad ^ 1) * 8); const float* cs = ROPE + (size_t)tcol * 16; float v[8];
#pragma unroll
        for (int i = 0; i < 8; ++i) { const float x = bf2f((bf16_t)qn[0][i]), y = bf2f((bf16_t)ot[i]); v[i] = quad == 0 ? x * cs[i] - y * cs[8 + i] : x * cs[i] + y * cs[8 + i]; }
        u32x4 o; o.x = pk2(v[0], v[1]); o.y = pk2(v[2], v[3]); o.z = pk2(v[4], v[5]); o.w = pk2(v[6], v[7]); qr[0] = __builtin_bit_cast(bf16x8, o); }
}
__device__ __forceinline__ void nsa_tile_pre(unsigned char* ws, LAS unsigned char* wl, LAS unsigned* blkmask, LAS unsigned char* kvb, int tid, int ncb, int t0, int g, int lane, f32x4 (&oc)[4]) {
    const bf16_t* FE = (const bf16_t*)(ws + OFF_ACT);
    LAS float* impA = (LAS float*)wl; LAS float* impB = impA + 1024; LAS int* sel = (LAS int*)(impB + 1024);
    const int col = lane & 15, quad = lane >> 4, tok = col >> 2, hl = col & 3, head = g * 4 + hl, tcol = t0 + tok;
    bf16x8 qn[2];
    { const bf16_t* qrow = FE + (size_t)tcol * IN_PAD + C_Q + head * 64; qn[0] = *(const bf16x8*)(qrow + quad * 8); qn[1] = *(const bf16x8*)(qrow + 32 + quad * 8); }
    const int nmax_col = tcol >= 31 ? (tcol - 31) >> 4 : -1;
    const bf16_t* KC = (const bf16_t*)(ws + OFF_KCMP) + (size_t)g * 1024 * 64;
    const bf16_t* VCT = (const bf16_t*)(ws + OFF_VCMPT) + (size_t)g * 64 * 1024;
    float ml = -1e30f, ll = 0.f;
    __syncthreads();
    { const u32x4 k0 = *(const u32x4*)(KC + tid * 8); *(LAS u32x4*)(kvb + tid * 16) = k0; }
    u32x4 rkA = {0u, 0u, 0u, 0u}, rkB = rkA, rvA = rkA, rvB = rkA;
    if (1 < ncb) rkA = *(const u32x4*)(KC + (size_t)1 * 4096 + tid * 8);
    if (2 < ncb) rkB = *(const u32x4*)(KC + (size_t)2 * 4096 + tid * 8);
    __syncthreads();
#define CMP1_STEP(jc, RK) if ((jc) < ncb) { \
        LAS unsigned char* cb = kvb + ((jc) & 1) * 16384; LAS unsigned char* nb = kvb + (((jc) + 1) & 1) * 16384; \
        _Pragma("unroll") for (int hf = 0; hf < 2; ++hf) { const int kb = (jc) * 64 + hf * 32; float sv[8]; float mx = -1e30f; \
            _Pragma("unroll") for (int a = 0; a < 2; ++a) { f32x4 s = {0.f, 0.f, 0.f, 0.f}; \
                _Pragma("unroll") for (int ks = 0; ks < 2; ++ks) { const bf16x8 kf = *(const LAS bf16x8*)(cb + (((2 * hf + a) * 2 + ks) * 512 + col * 32 + quad * 8) * 2); s = __builtin_amdgcn_mfma_f32_16x16x32_bf16(kf, qn[ks], s, 0, 0, 0); } \
                _Pragma("unroll") for (int r = 0; r < 4; ++r) { const int n = kb + 16 * a + quad * 4 + r; sv[a * 4 + r] = n <= nmax_col ? s[r] * QK_SCALE2 : -1e30f; mx = fmaxf(mx, sv[a * 4 + r]); } } \
            const float mn = fmaxf(ml, mx); float ps = 0.f; \
            _Pragma("unroll") for (int i = 0; i < 8; ++i) ps += sv[i] > -1e29f ? __builtin_amdgcn_exp2f(sv[i] - mn) : 0.f; \
            ll = ll * __builtin_amdgcn_exp2f(ml - mn) + ps; ml = mn; } \
        if ((jc) + 1 < ncb) *(LAS u32x4*)(nb + tid * 16) = RK; \
        if ((jc) + 3 < ncb) RK = *(const u32x4*)(KC + (size_t)((jc) + 3) * 4096 + tid * 8); \
        SCAN_BAR(); }
    for (int jc = 0; jc < ncb; jc += 2) { CMP1_STEP(jc, rkA) CMP1_STEP(jc + 1, rkB) }
#undef CMP1_STEP
    const float M = quad_allmax(ml);
    const float L = quad_allsum(ll * __builtin_amdgcn_exp2f(ml - M));
    const float invL = L > 0.f ? 1.f / L : 0.f;
#pragma unroll
    for (int i = 0; i < 32; ++i) impA[i * 64 + lane] = 0.f;
    LDS_WAIT();
#pragma unroll
    for (int i = 0; i < 4; ++i) oc[i] = (f32x4){0.f, 0.f, 0.f, 0.f};
    __syncthreads();
    { const u32x4 k0 = *(const u32x4*)(KC + tid * 8), v0 = *(const u32x4*)(VCT + tid * 8); *(LAS u32x4*)(kvb + tid * 16) = k0; *(LAS u32x4*)(kvb + 8192 + tid * 16) = v0; }
    if (1 < ncb) { rkA = *(const u32x4*)(KC + (size_t)1 * 4096 + tid * 8); rvA = *(const u32x4*)(VCT + (size_t)1 * 4096 + tid * 8); }
    if (2 < ncb) { rkB = *(const u32x4*)(KC + (size_t)2 * 4096 + tid * 8); rvB = *(const u32x4*)(VCT + (size_t)2 * 4096 + tid * 8); }
    __syncthreads();
#define CMP2_STEP(jc, RK, RV) if ((jc) < ncb) { \
        LAS unsigned char* cb = kvb + ((jc) & 1) * 16384; LAS unsigned char* nb = kvb + (((jc) + 1) & 1) * 16384; \
        _Pragma("unroll") for (int hf = 0; hf < 2; ++hf) { const int kb = (jc) * 64 + hf * 32; f32x4 pr[2]; \
            _Pragma("unroll") for (int a = 0; a < 2; ++a) { f32x4 s = {0.f, 0.f, 0.f, 0.f}; \
                _Pragma("unroll") for (int ks = 0; ks < 2; ++ks) { const bf16x8 kf = *(const LAS bf16x8*)(cb + (((2 * hf + a) * 2 + ks) * 512 + col * 32 + quad * 8) * 2); s = __builtin_amdgcn_mfma_f32_16x16x32_bf16(kf, qn[ks], s, 0, 0, 0); } \
                _Pragma("unroll") for (int r = 0; r < 4; ++r) { const int n = kb + 16 * a + quad * 4 + r; pr[a][r] = n <= nmax_col ? __builtin_amdgcn_exp2f(s[r] * QK_SCALE2 - M) * invL : 0.f; } } \
            const bf16x8 pf = pack8(pr[0], pr[1]); \
            _Pragma("unroll") for (int dt = 0; dt < 4; ++dt) { const bf16x8 vf = *(const LAS bf16x8*)(cb + 8192 + (hf * 2048 + dt * 512 + col * 32 + quad * 8) * 2); \
                oc[dt] = __builtin_amdgcn_mfma_f32_16x16x32_bf16(vf, pf, oc[dt], 0, 0, 0); } \
            _Pragma("unroll") for (int a = 0; a < 2; ++a) { float s4 = (pr[a][0] + pr[a][1]) + (pr[a][2] + pr[a][3]), p3 = pr[a][3]; \
                s4 += dppf<0xB1>(s4); s4 += dppf<0x4E>(s4); p3 += dppf<0xB1>(p3); p3 += dppf<0x4E>(p3); \
                const int jj = ((kb + 16 * a) >> 2) + quad; \
                if (hl == 0 && jj < 256) { impA[tok * 256 + jj] = s4; if (jj + 1 < 256) impB[tok * 256 + jj + 1] = p3; } } } \
        if ((jc) + 1 < ncb) { *(LAS u32x4*)(nb + tid * 16) = RK; *(LAS u32x4*)(nb + 8192 + tid * 16) = RV; } \
        if ((jc) + 3 < ncb) { RK = *(const u32x4*)(KC + (size_t)((jc) + 3) * 4096 + tid * 8); RV = *(const u32x4*)(VCT + (size_t)((jc) + 3) * 4096 + tid * 8); } \
        SCAN_BAR(); }
    for (int jc = 0; jc < ncb; jc += 2) { CMP2_STEP(jc, rkA, rvA) CMP2_STEP(jc + 1, rkB, rvB) }
#undef CMP2_STEP
    LDS_WAIT();
    for (int tk = 0; tk < 4; ++tk) { const int t = t0 + tk, cur = t >> 6; int cnt = 0;
        if (lane == 0) { sel[tk * 16 + 0] = 0; if (cur >= 1) sel[tk * 16 + 1] = cur; if (cur >= 2) sel[tk * 16 + 2] = cur - 1; }
        cnt = cur == 0 ? 1 : (cur == 1 ? 2 : 3);
        const int ncand = cur >= 2 ? cur - 2 : 0, nfree = 16 - cnt;
        if (ncand <= nfree) { if (lane < ncand) sel[tk * 16 + cnt + lane] = 1 + lane; cnt += ncand; }
        else {
            unsigned v[4];
#pragma unroll
            for (int i = 0; i < 4; ++i) { const int j = lane * 4 + i; v[i] = (j >= 1 && j <= cur - 2) ? ((__float_as_uint(impA[tk * 256 + j] + impB[tk * 256 + j]) & 0xFFFFFF00u) | (unsigned)(255 - j)) : 0u; }
            const int ti_ = (t0 & 63) + tk; LAS unsigned* mrow = blkmask + (ti_ >> 5); const unsigned bit_ = 1u << (ti_ & 31);
            for (int rd = 0; rd < nfree; ++rd) {
                const unsigned wm = wave_max_u(umax_(umax_(v[0], v[1]), umax_(v[2], v[3])));
#pragma unroll
                for (int i = 0; i < 4; ++i) v[i] = (v[i] == wm) ? 0u : v[i];
                const int bj = 255 - (int)(__builtin_amdgcn_readfirstlane(wm) & 0xFFu);
                if (lane == 0) __hip_atomic_fetch_or(mrow + 2 * bj, bit_, __ATOMIC_RELAXED, __HIP_MEMORY_SCOPE_WORKGROUP); } }
        LDS_WAIT();
        if (lane < cnt) { const int j = sel[tk * 16 + lane]; const int ti = (t0 & 63) + tk;
            __hip_atomic_fetch_or(blkmask + 2 * j + (ti >> 5), 1u << (ti & 31), __ATOMIC_RELAXED, __HIP_MEMORY_SCOPE_WORKGROUP); } }
    LDS_WAIT();
}
__device__ __forceinline__ void nsa_tile_add(unsigned char* ws, int t0, int g, int lane, const Flash& fb, int gi) {
    const bf16_t* FE = (const bf16_t*)(ws + OFF_ACT);
    const int col = lane & 15, quad = lane >> 4, tok = col >> 2, hl = col & 3, head = g * 4 + hl, tcol = t0 + tok;
    const float gb = sigmoidf_(bf2f(FE[(size_t)tcol * IN_PAD + C_GL + gi + head])) * flash_finish(fb);
    bf16_t* yo = (bf16_t*)(ws + OFF_XN) + (size_t)tcol * D_ + 1024 + head * 64 + quad * 4;
#pragma unroll
    for (int dt = 0; dt < 4; ++dt) { const u32x2 pc = *(const u32x2*)(yo + dt * 16);
        f32x4 o = gb * fb.o[dt];
        o[0] += __uint_as_float(pc.x << 16); o[1] += __uint_as_float(pc.x & 0xffff0000u); o[2] += __uint_as_float(pc.y << 16); o[3] += __uint_as_float(pc.y & 0xffff0000u);
        u32x2 v; v.x = pk2(o[0], o[1]); v.y = pk2(o[2], o[3]); *(u32x2*)(yo + dt * 16) = v; }
}
constexpr int NI_MASK = 0, NI_ID = 2048, NI_KV = 4096, NI_KVB = 4096 + 8 * NSA_WLDS;
__device__ __forceinline__ void nsa_item(unsigned char* ws, LAS unsigned char* lds, int qb, int g, int wave, int lane) {
    asm volatile("" : "+v"(lane));
    const bf16_t* FE = (const bf16_t*)(ws + OFF_ACT); const float* ROPE = (const float*)(ws + OFF_ROPE);
    LAS unsigned* blkmask = (LAS unsigned*)(lds + NI_MASK);
    LAS unsigned char* wl = lds + NI_KV + wave * NSA_WLDS;
    const int tid = wave * 64 + lane, col = lane & 15, quad = lane >> 4, tok = col >> 2, hl = col & 3, head = g * 4 + hl;
    const int tw = qb * 64 + wave * 8;
    blkmask[tid] = 0u;
    __syncthreads();
    for (int c = 0; c < 2; ++c) {
        f32x4 oc[4]; const int t0 = tw + 4 * c;
        nsa_tile_pre(ws, wl, blkmask, lds + NI_KVB, tid, ((4 * qb + 2) >> 6) + 1, t0, g, lane, oc);
        const float gc = sigmoidf_(bf2f(FE[(size_t)(t0 + tok) * IN_PAD + C_GL + head]));
        bf16_t* yo = (bf16_t*)(ws + OFF_XN) + (size_t)(t0 + tok) * D_ + 1024 + head * 64 + quad * 4;
#pragma unroll
        for (int dt = 0; dt < 4; ++dt) { u32x2 v; v.x = pk2(gc * oc[dt][0], gc * oc[dt][1]); v.y = pk2(gc * oc[dt][2], gc * oc[dt][3]); *(u32x2*)(yo + dt * 16) = v; } }
    __syncthreads();
    const bf16_t* KS = (const bf16_t*)(ws + OFF_KSR) + (size_t)g * S_ * 64;
    const bf16_t* VS = (const bf16_t*)(ws + OFF_VST) + (size_t)g * S_ * 64;
    LAS unsigned char* kvb = lds + NI_KVB;
    {
        bf16x8 qn[2], qr0[2], qr1[2];
        nsa_q(FE, ROPE, tw + tok, head, quad, qn, qr0);
        nsa_q(FE, ROPE, tw + 4 + tok, head, quad, qn, qr1);
        Flash f0, f1; flash_init(f0); flash_init(f1);
        __syncthreads();
        { const u32x4 k0 = *(const u32x4*)(KS + tid * 8), v0 = *(const u32x4*)(VS + tid * 8);
          *(LAS u32x4*)(kvb + tid * 16) = k0; *(LAS u32x4*)(kvb + 8192 + tid * 16) = v0; }
        u32x4 rk = {0u, 0u, 0u, 0u}, rv = rk;
        __syncthreads();
        for (int j = 0; j <= qb; ++j) {
            LAS unsigned char* cb = kvb + (j & 1) * 16384; LAS unsigned char* nb = kvb + ((j + 1) & 1) * 16384;
            if (j < qb) { rk = *(const u32x4*)(KS + (size_t)(j + 1) * 4096 + tid * 8); rv = *(const u32x4*)(VS + (size_t)(j + 1) * 4096 + tid * 8); }
            unsigned my8 = 0xFFu;
            if (j < qb) { const unsigned mw = __builtin_amdgcn_readfirstlane(blkmask[2 * j + (wave >> 2)]); my8 = (mw >> ((wave & 3) * 8)) & 0xFFu; }
            if (my8) {
                KV64 x;
#pragma unroll
                for (int a = 0; a < 4; ++a)
#pragma unroll
                    for (int ks = 0; ks < 2; ++ks) x.k[a][ks] = *(const LAS bf16x8*)(cb + ((a * 2 + ks) * 512 + col * 32 + quad * 8) * 2);
#pragma unroll
                for (int h = 0; h < 2; ++h)
#pragma unroll
                    for (int dt = 0; dt < 4; ++dt) x.v[h][dt] = *(const LAS bf16x8*)(cb + 8192 + (h * 2048 + dt * 512 + col * 32 + quad * 8) * 2);
                const unsigned b0 = my8 & 0xFu, b1 = my8 >> 4;
                if (j < qb) { if (b0) flash_block64v(f0, qr0, x, (b0 >> tok) & 1u); if (b1) flash_block64v(f1, qr1, x, (b1 >> tok) & 1u); }
                else { flash_block64(f0, qr0, x, qb * 64, 0, tw + tok, true, quad); flash_block64(f1, qr1, x, qb * 64, 0, tw + 4 + tok, true, quad); }
            }
            if (j < qb) { *(LAS u32x4*)(nb + tid * 16) = rk; *(LAS u32x4*)(nb + 8192 + tid * 16) = rv; }
            SCAN_BAR();
        }
        nsa_tile_add(ws, tw, g, lane, f0, 16); nsa_tile_add(ws, tw + 4, g, lane, f1, 16);
        flash_init(f0); flash_init(f1);
        { const bf16_t* KW = (const bf16_t*)(ws + OFF_KWR) + (size_t)g * S_ * 64;
          const bf16_t* VW = (const bf16_t*)(ws + OFF_VWT) + (size_t)g * S_ * 64;
          const int jw0 = qb >= 8 ? qb - 8 : 0;
          __syncthreads();
          rk = *(const u32x4*)(KW + (size_t)jw0 * 4096 + tid * 8); rv = *(const u32x4*)(VW + (size_t)jw0 * 4096 + tid * 8);
          *(LAS u32x4*)(kvb + (jw0 & 1) * 16384 + tid * 16) = rk; *(LAS u32x4*)(kvb + (jw0 & 1) * 16384 + 8192 + tid * 16) = rv;
          __syncthreads();
          for (int j = jw0; j <= qb; ++j) {
              LAS unsigned char* cb = kvb + (j & 1) * 16384; LAS unsigned char* nb = kvb + ((j + 1) & 1) * 16384;
              if (j < qb) { rk = *(const u32x4*)(KW + (size_t)(j + 1) * 4096 + tid * 8); rv = *(const u32x4*)(VW + (size_t)(j + 1) * 4096 + tid * 8); }
              KV64 x;
#pragma unroll
              for (int a = 0; a < 4; ++a)
#pragma unroll
                  for (int ks = 0; ks < 2; ++ks) x.k[a][ks] = *(const LAS bf16x8*)(cb + ((a * 2 + ks) * 512 + col * 32 + quad * 8) * 2);
#pragma unroll
              for (int h = 0; h < 2; ++h)
#pragma unroll
                  for (int dt = 0; dt < 4; ++dt) x.v[h][dt] = *(const LAS bf16x8*)(cb + 8192 + (h * 2048 + dt * 512 + col * 32 + quad * 8) * 2);
              if (j == qb || j + 8 == qb) { flash_block64(f0, qr0, x, j * 64, tw + tok - 511, tw + tok, true, quad); flash_block64(f1, qr1, x, j * 64, tw + 4 + tok - 511, tw + 4 + tok, true, quad); }
              else { flash_block64v(f0, qr0, x, true); flash_block64v(f1, qr1, x, true); }
              if (j < qb) { *(LAS u32x4*)(nb + tid * 16) = rk; *(LAS u32x4*)(nb + 8192 + tid * 16) = rv; }
              SCAN_BAR();
          } }
        nsa_tile_add(ws, tw, g, lane, f0, 32); nsa_tile_add(ws, tw + 4, g, lane, f1, 32);
    }
}

__device__ __forceinline__ void mem_attn_task(unsigned char* ws, int task, int lane) {
    const int h = task & 3, t0 = (task >> 2) * 16, col = lane & 15, quad = lane >> 4;
    const bf16_t* QM = (const bf16_t*)(ws + OFF_QM); const bf16_t* KM = (const bf16_t*)(ws + OFF_KM); const bf16_t* VMT = (const bf16_t*)(ws + OFF_VMT);
    bf16x8 q[4];
#pragma unroll
    for (int ks = 0; ks < 4; ++ks) q[ks] = *(const bf16x8*)(QM + (size_t)(t0 + col) * 512 + h * 128 + ks * 32 + quad * 8);
    float m = -1e30f, l = 0.f; f32x4 o[8];
#pragma unroll
    for (int i = 0; i < 8; ++i) o[i] = (f32x4){0.f, 0.f, 0.f, 0.f};
    const float sc = 0.08838834764831845f;
    for (int kb = 0; kb < 256; kb += 32) { f32x4 s[2]; float mx = -1e30f;
#pragma unroll
        for (int a = 0; a < 2; ++a) { s[a] = (f32x4){0.f, 0.f, 0.f, 0.f}; const bf16_t* kr = KM + (size_t)(kb + 16 * a + col) * 512 + h * 128 + quad * 8;
#pragma unroll
            for (int ks = 0; ks < 4; ++ks) { const bf16x8 kf = *(const bf16x8*)(kr + ks * 32); s[a] = __builtin_amdgcn_mfma_f32_16x16x32_bf16(kf, q[ks], s[a], 0, 0, 0); }
#pragma unroll
            for (int r = 0; r < 4; ++r) { s[a][r] *= sc; mx = fmaxf(mx, s[a][r]); } }
        mx = fmaxf(mx, __shfl_xor(mx, 16)); mx = fmaxf(mx, __shfl_xor(mx, 32));
        const float mn = fmaxf(m, mx), alpha = __expf(m - mn); m = mn; float ps = 0.f;
#pragma unroll
        for (int a = 0; a < 2; ++a)
#pragma unroll
            for (int r = 0; r < 4; ++r) { s[a][r] = __expf(s[a][r] - mn); ps += s[a][r]; }
        l = l * alpha + ps;
        const bf16x8 pf = pack8(s[0], s[1]);
#pragma unroll
        for (int dt = 0; dt < 8; ++dt) { const bf16_t* vr = VMT + (size_t)(h * 128 + dt * 16 + col) * 256 + kb + quad * 4; const bf16x8 vf = ld2x4(vr, vr + 16);
            o[dt] *= alpha; o[dt] = __builtin_amdgcn_mfma_f32_16x16x32_bf16(vf, pf, o[dt], 0, 0, 0); } }
    l += __shfl_xor(l, 16); l += __shfl_xor(l, 32); const float inv = 1.f / l;
    bf16_t* om = (bf16_t*)(ws + OFF_OM) + (size_t)(t0 + col) * 512 + h * 128 + quad * 4;
#pragma unroll
    for (int dt = 0; dt < 8; ++dt) { u32x2 v; v.x = pk2(o[dt][0] * inv, o[dt][1] * inv); v.y = pk2(o[dt][2] * inv, o[dt][3] * inv); *(u32x2*)(om + dt * 16) = v; }
}


__device__ __forceinline__ void gsync(unsigned* bar, unsigned target, int wave_s) {
    asm volatile("s_waitcnt vmcnt(0) lgkmcnt(0)" ::: "memory");
    __syncthreads();
    if (wave_s == 0) { int lane; asm volatile("v_mbcnt_lo_u32_b32 %0, -1, 0\n\tv_mbcnt_hi_u32_b32 %0, -1, %0" : "=v"(lane));
        if (lane == 0) { __builtin_amdgcn_fence(__ATOMIC_RELEASE, "agent");
            asm volatile("s_waitcnt vmcnt(0)" ::: "memory");
            __hip_atomic_fetch_add(bar, 1u, __ATOMIC_RELAXED, __HIP_MEMORY_SCOPE_AGENT);
            while (__hip_atomic_load(bar, __ATOMIC_RELAXED, __HIP_MEMORY_SCOPE_AGENT) < target) __builtin_amdgcn_s_sleep(20); } }
    __syncthreads();
    __builtin_amdgcn_fence(__ATOMIC_ACQUIRE, "agent");
    asm volatile("s_waitcnt vmcnt(0)" ::: "memory");
}
__device__ __forceinline__ void ffn_phases(unsigned* bar, unsigned& bar_t, LAS unsigned char* lds, unsigned char* ws, bf16_t* XN, bf16_t* ACT, bf16_t* Y, int G, int bid, const int wave_s) {
    { pg8::StaticOrder so; so.init(S_, 2 * FF_, G, bid);
      pg8::Gemm g{XN, (const bf16_t*)(ws + OFF_WGU), S_, 2 * FF_, D_};
      pg8::EpiSwiGLU e{ACT, FF_};
      pg8::gemm_phase(lds, g, so, e, wave_s); }
    bar_t += G; gsync(bar, bar_t, wave_s);
    { pg8::StaticOrder so; so.init(S_, D_, G, bid);
      pg8::Gemm g{ACT, (const bf16_t*)(ws + OFF_WD), S_, D_, FF_};
      pg8::EpiBf16 e{Y, D_};
      pg8::gemm_phase(lds, g, so, e, wave_s); }
    bar_t += G; gsync(bar, bar_t, wave_s);
}

__global__ void __launch_bounds__(512, 2) hymba_fwd(Params p) {
    extern __shared__ __attribute__((aligned(16))) unsigned char shm[];
    cg::grid_group grid = cg::this_grid();
    LAS unsigned char* lds = (LAS unsigned char*)shm;
    const int G = gridDim.x, bid = blockIdx.x;
    const int NGW = G * 8, NT = G * 512;
    unsigned char* ws = p.ws;
    bf16_t* XN = (bf16_t*)(ws + OFF_XN);
    bf16_t* ACT = (bf16_t*)(ws + OFF_ACT);
    bf16_t* Y = (bf16_t*)(ws + OFF_Y);
    unsigned* ctr = (unsigned*)(ws + OFF_CTR);
    unsigned* bar = ctr + 64; unsigned bar_t = 0;
    const int wave_s = __builtin_amdgcn_readfirstlane(threadIdx.x >> 6);
#define PHASE_IDX() int lane; asm volatile("v_mbcnt_lo_u32_b32 %0, -1, 0\n\tv_mbcnt_hi_u32_b32 %0, -1, %0" : "=v"(lane)); const int wave = wave_s; const int tid = wave * 64 + lane; (void)tid; const int gw = bid * 8 + wave, gtid = bid * 512 + tid; (void)gtid; (void)gw; (void)lane; LAS float* scr = (LAS float*)(lds + wave * 16384); (void)scr;

    {
        PHASE_IDX();
        conv_gateup(p.in[3], p.in[4], (bf16_t*)(ws + OFF_WGU), scr, lane, gw, NGW);
        conv_plain(p.in[5], FF_, D_, D_, (bf16_t*)(ws + OFF_WD), scr, lane, gw, NGW);
        conv_plain(p.in[8], D_, IN_COLS, IN_PAD, (bf16_t*)(ws + OFF_WIN), scr, lane, gw, NGW);
        conv_plain(p.in[26], D_, D_, D_, (bf16_t*)(ws + OFF_WOUT), scr, lane, gw, NGW);
        conv_plain(p.in[30], D_, 512, 512, (bf16_t*)(ws + OFF_WMQ), scr, lane, gw, NGW);
        conv_plain(p.in[32], 512, D_, D_, (bf16_t*)(ws + OFF_WMO), scr, lane, gw, NGW);
        conv_plain(p.in[31], D_, 1024, 1024, (bf16_t*)(ws + OFF_WMKV), scr, lane, gw, NGW);
        conv_plain(p.in[21], 2048, 128, 128, (bf16_t*)(ws + OFF_WC1K), scr, lane, gw, NGW);
        conv_plain(p.in[24], 2048, 128, 128, (bf16_t*)(ws + OFF_WC1V), scr, lane, gw, NGW);
        conv_plain(p.in[22], 128, 64, 64, (bf16_t*)(ws + OFF_WC2K), scr, lane, gw, NGW);
        conv_plain(p.in[25], 128, 64, 64, (bf16_t*)(ws + OFF_WC2V), scr, lane, gw, NGW);
        for (int row = gw; row < S_; row += NGW) rms_row_to_bf16(p.in[0] + (size_t)row * D_, p.in[2], XN + (size_t)row * D_, lane);
        for (int row = gw; row < MEM_; row += NGW) rms_row_to_bf16(p.in[1] + (size_t)row * D_, p.in[29], (bf16_t*)(ws + OFF_MEMN) + (size_t)row * D_, lane);
        { bf16_t* WL = (bf16_t*)(ws + OFF_WLORA);
          for (int i = gtid; i < LORA_N * LORA_K; i += NT) { const int n = i / LORA_K, k = i % LORA_K; float v = 0.f;
              if (n < 1024) { if (k < 64) v = p.in[11][k * 1024 + n]; }
              else if (n < 2048) { if (k >= 64 && k < 128) v = p.in[13][(k - 64) * 1024 + n - 1024]; }
              else { if (k >= 128 && k < 288) v = p.in[14][(k - 128) * 1024 + n - 2048]; }
              WL[i] = f2bf(v); } }
        { float* RP = (float*)(ws + OFF_ROPE);
          for (int i = gtid; i < S_ * 8; i += NT) { const int pos = i >> 3, f = i & 7;
              const float fr = f == 0 ? 1.000000000e+00f : f == 1 ? 1.939227432e-01f : f == 2 ? 3.760603070e-02f : f == 3 ? 7.292664610e-03f : f == 4 ? 1.414213562e-03f : f == 5 ? 2.742481884e-04f : f == 6 ? 5.318296098e-05f : 1.031338616e-05f;
              const float ang = (float)pos * fr;
              const double rev = (double)ang * 0.15915494309189535; const double fc = rev - rint(rev);
              const float rr = (float)(fc * 6.283185307179586);
              RP[pos * 16 + f] = cosf(rr); RP[pos * 16 + 8 + f] = sinf(rr); } }
    }
    grid.sync();
    ffn_phases(bar, bar_t, lds, ws, XN, ACT, Y, G, bid, wave_s);
    { PHASE_IDX(); norm_phase(p.in[0], Y, 0.5f, p.in[6], p.out, p.in[7], XN, lane, gw, NGW); }
    bar_t += G; gsync(bar, bar_t, wave_s);
    { pg8::StaticOrder so; so.init(S_, IN_PAD, G, bid);
      pg8::Gemm g{XN, (const bf16_t*)(ws + OFF_WIN), S_, IN_PAD, D_};
      pg8::EpiBf16 e{ACT, IN_PAD};
      pg8::gemm_phase(lds, g, so, e, wave_s); }
    bar_t += G; gsync(bar, bar_t, wave_s);
    {
        PHASE_IDX();
        const bf16_t* FE = ACT;
        if (wave < 2) { for (int task = bid * 2 + wave; task < 512; task += G * 2) compress_task(p, ws, task, lane); }
        else {
        const int gtid = (bid * 6 + wave - 2) * 64 + lane, NT = G * 384;
        { float* KN2 = (float*)(ws + OFF_KN2);
          for (int pr = bid * 6 + wave - 2; pr < S_ * 16; pr += G * 6) { const int t = pr >> 4, c = (pr & 15) * 64 + lane;
              const float kx = shiftv(FE, t, C_K + c, p.in[9][C_K + c]) * p.in[15][c]; const float ss = wave_sum(kx * kx);
              if (lane == 0) KN2[pr] = __builtin_amdgcn_rsqf(fmaxf(ss, 1e-24f)); } }
        { bf16_t* XL = (bf16_t*)(ws + OFF_XL);
          for (int i = gtid; i < S_ * LORA_K; i += NT) { const int t = i / LORA_K, c = i % LORA_K; float v = 0.f;
              if (c < 288) { const float s = shiftv(FE, t, C_WD + c, p.in[9][C_WD + c]); v = c < 64 ? tanhf_(s) : (c < 128 ? s : sigmoidf_(s)); }
              XL[i] = f2bf(v); } }
        { const float* RP = (const float*)(ws + OFF_ROPE);
          for (int i = gtid; i < S_ * 4 * 2; i += NT) { const int which = i & 1, g = (i >> 1) & 3, t = i >> 3;
              const bf16_t* srcp = FE + (size_t)t * IN_PAD + (which ? C_KW : C_KS) + g * 64;
              bf16_t* dstp = (bf16_t*)(ws + (which ? OFF_KWR : OFF_KSR)) + ((size_t)g * (S_ / 16) + (t >> 4)) * 1024 + (t & 15) * 32;
              const bf16x8 a = *(const bf16x8*)srcp, b = *(const bf16x8*)(srcp + 8); const float* cs = RP + (size_t)t * 16; float va[8], vb[8];
#pragma unroll
              for (int j = 0; j < 8; ++j) { const float x1 = bf2f((bf16_t)a[j]), x2 = bf2f((bf16_t)b[j]); va[j] = x1 * cs[j] - x2 * cs[8 + j]; vb[j] = x2 * cs[j] + x1 * cs[8 + j]; }
              u32x4 o; o.x = pk2(va[0], va[1]); o.y = pk2(va[2], va[3]); o.z = pk2(va[4], va[5]); o.w = pk2(va[6], va[7]); *(u32x4*)dstp = o;
              o.x = pk2(vb[0], vb[1]); o.y = pk2(vb[2], vb[3]); o.z = pk2(vb[4], vb[5]); o.w = pk2(vb[6], vb[7]); *(u32x4*)(dstp + 8) = o;
#pragma unroll
              for (int j = 2; j < 8; ++j) *(u32x4*)(dstp + (j >> 2) * 512 + (j & 3) * 8) = *(const u32x4*)(srcp + j * 8); } }
        { for (int i = gtid; i < 2 * 256 * (S_ / 8); i += NT) { const int gd = i & 255, which = (i >> 8) & 1, tc = i >> 9;
              const bf16_t* srcp = FE + (size_t)tc * 8 * IN_PAD + (which ? C_VW : C_VS) + gd;
              bf16_t v[8];
#pragma unroll
              for (int j = 0; j < 8; ++j) v[j] = srcp[(size_t)j * IN_PAD];
              u32x4 o; o.x = v[0] | ((unsigned)v[1] << 16); o.y = v[2] | ((unsigned)v[3] << 16); o.z = v[4] | ((unsigned)v[5] << 16); o.w = v[6] | ((unsigned)v[7] << 16);
              bf16_t* dv = (bf16_t*)(ws + (which ? OFF_VWT : OFF_VST)) + (((size_t)(gd >> 6) * (S_ / 32) + (tc >> 2)) * 4 + ((gd & 63) >> 4)) * 512 + (gd & 15) * 32 + (tc & 1) * 16 + ((tc & 3) >> 1) * 4;
              u32x2 lo2; lo2.x = o.x; lo2.y = o.y; u32x2 hi2; hi2.x = o.z; hi2.y = o.w; *(u32x2*)dv = lo2; *(u32x2*)(dv + 8) = hi2; } }
        }
    }
    bar_t += G; gsync(bar, bar_t, wave_s);
    { pg8::StaticOrder so; so.init(S_, LORA_N, G, bid);
      pg8::Gemm g{(const bf16_t*)(ws + OFF_XL), (const bf16_t*)(ws + OFF_WLORA), S_, LORA_N, LORA_K};
      EpiLora e{(bf16_t*)(ws + OFF_LORA), p.in[10], p.in[12]};
      pg8::gemm_phase(lds, g, so, e, wave_s); }
    bar_t += G; gsync(bar, bar_t, wave_s);
    { PHASE_IDX();
    if (bid < 64) { rwkv_scan_block(p, ws, lds, bid, tid); }
    { {
        const int g0 = (int)(__builtin_amdgcn_s_getreg((3 << 11) | 20) & 3u);
        LAS unsigned* idw = (LAS unsigned*)(lds + NI_ID);
        for (int gi = 0; gi < 4; ++gi) { const int g = (g0 + gi) & 3;
          for (;;) { __syncthreads();
            if (tid == 0) *idw = atomicAdd(ctr + g, 1u);
            __syncthreads();
            const unsigned id = __builtin_amdgcn_readfirstlane(*idw);
            if (id >= (unsigned)(S_ / 64)) break;
            nsa_item(ws, lds, (S_ / 64 - 1) - (int)id, g, wave, lane); } } }
    } }
    bar_t += G; gsync(bar, bar_t, wave_s);
    {
        PHASE_IDX();
        const bf16_t* FE = ACT; const bf16_t* LO = (const bf16_t*)(ws + OFF_LORA); const bf16_t* YR = (const bf16_t*)(ws + OFF_YRAW);
        for (int task = gw; task < S_ * 4; task += NGW) { const int t4 = (task >> 4) * 4, h = task & 15, c = h * 64 + lane;
            const float mu_r = p.in[9][C_R + c], mu_k = p.in[9][C_K + c], mu_v = p.in[9][C_V + c], lnw = p.in[18][c], lnb = p.in[19][c], kaw = p.in[16][c], rkw = p.in[17][c];
            float fr[5], fk[5], fv[5], yy[4], aa[4], gg[4];
#pragma unroll
            for (int i = 0; i < 5; ++i) { const int t = t4 - 1 + i;
                if (t >= 0) { fr[i] = bf2f(FE[(size_t)t * IN_PAD + C_R + c]); fk[i] = bf2f(FE[(size_t)t * IN_PAD + C_K + c]); fv[i] = bf2f(FE[(size_t)t * IN_PAD + C_V + c]); }
                else { fr[i] = 0.f; fk[i] = 0.f; fv[i] = 0.f; } }
#pragma unroll
            for (int i = 0; i < 4; ++i) { const int t = t4 + i; yy[i] = bf2f(YR[(size_t)t * 1024 + c]); aa[i] = bf2f(LO[(size_t)t * LORA_N + 1024 + c]); gg[i] = bf2f(LO[(size_t)t * LORA_N + 2048 + c]); }
#pragma unroll
            for (int i = 0; i < 4; ++i) {
                const float y = yy[i]; const float mean = wave_sum(y) * (1.f / 64.f); const float d = y - mean; const float var = wave_sum(d * d) * (1.f / 64.f);
                const float yn = d * rsqrtf(var + 64e-5f) * lnw + lnb;
                const float r = fr[i + 1] + mu_r * (fr[i] - fr[i + 1]), k = fk[i + 1] + mu_k * (fk[i] - fk[i + 1]), v = fv[i + 1] + mu_v * (fv[i] - fv[i + 1]);
                const float kp = k * (1.f + (aa[i] - 1.f) * kaw);
                const float bonus = wave_sum(r * kp * rkw) * v;
                XN[(size_t)(t4 + i) * D_ + c] = f2bf((yn + bonus) * gg[i]); } }
    }
    bar_t += G; gsync(bar, bar_t, wave_s);
    { pg8::StaticOrder so; so.init(S_, D_, G, bid);
      pg8::Gemm g{XN, (const bf16_t*)(ws + OFF_WOUT), S_, D_, D_};
      pg8::EpiBf16 e{Y, D_};
      pg8::gemm_phase(lds, g, so, e, wave_s); }
    bar_t += G; gsync(bar, bar_t, wave_s);
    { PHASE_IDX();
    norm_phase(p.out, Y, 1.0f, p.in[27], p.out, p.in[28], XN, lane, gw, NGW);
    conv_gateup(p.in[35], p.in[36], (bf16_t*)(ws + OFF_WGU), scr, lane, gw, NGW);
    conv_plain(p.in[37], FF_, D_, D_, (bf16_t*)(ws + OFF_WD), scr, lane, gw, NGW); }
    bar_t += G; gsync(bar, bar_t, wave_s);
    { pg8::StaticOrder so; so.init(S_, 512, G, bid);
      pg8::Gemm g{XN, (const bf16_t*)(ws + OFF_WMQ), S_, 512, D_};
      pg8::EpiBf16 e{(bf16_t*)(ws + OFF_QM), 512};
      pg8::gemm_phase(lds, g, so, e, wave_s); }
    if (bid >= 128) {
        PHASE_IDX();
        const int kw = (bid - 128) * 8 + wave, KNW = (G - 128) * 8;
        for (int task = kw; task < 1024; task += KNW) { const int mt = task >> 6, nt = task & 63; const int col = lane & 15, quad = lane >> 4;
            const f32x4 c = wave_tile_gemm((const bf16_t*)(ws + OFF_MEMN) + (size_t)mt * 16 * D_, D_, (const bf16_t*)(ws + OFF_WMKV) + (size_t)nt * 16 * D_, D_, D_, lane);
            const int cc = nt * 16 + col, key = mt * 16 + quad * 4;
            if (cc < 512) { bf16_t* K = (bf16_t*)(ws + OFF_KM);
#pragma unroll
                for (int r = 0; r < 4; ++r) K[(size_t)(key + r) * 512 + cc] = f2bf(c[r]); }
            else { bf16_t* V = (bf16_t*)(ws + OFF_VMT) + (size_t)(cc - 512) * 256 + key; u32x2 v; v.x = pk2(c[0], c[1]); v.y = pk2(c[2], c[3]); *(u32x2*)V = v; } }
    }
    bar_t += G; gsync(bar, bar_t, wave_s);
    { PHASE_IDX(); for (int task = gw; task < (S_ / 16) * 4; task += NGW) mem_attn_task(ws, task, lane); }
    bar_t += G; gsync(bar, bar_t, wave_s);
    { pg8::StaticOrder so; so.init(S_, D_, G, bid);
      pg8::Gemm g{(const bf16_t*)(ws + OFF_OM), (const bf16_t*)(ws + OFF_WMO), S_, D_, 512};
      pg8::EpiBf16 e{Y, D_};
      pg8::gemm_phase(lds, g, so, e, wave_s); }
    bar_t += G; gsync(bar, bar_t, wave_s);
    { PHASE_IDX(); norm_phase(p.out, Y, 1.0f, p.in[33], p.out, p.in[34], XN, lane, gw, NGW); }
    bar_t += G; gsync(bar, bar_t, wave_s);
    ffn_phases(bar, bar_t, lds, ws, XN, ACT, Y, G, bid, wave_s);
    { PHASE_IDX(); norm_phase(p.out, Y, 0.5f, p.in[38], p.out, nullptr, XN, lane, gw, NGW); }
}

extern "C" void kernel_launch(void* const* d_in, const int* in_sizes, int n_in, void* d_out, int out_size, void* d_ws, size_t ws_size, hipStream_t stream) {
    constexpr size_t kDynLds = 131072;
    static int grid_blocks = 0;
    if (!grid_blocks) {
        if (n_in != 39 || out_size != S_ * D_ || ws_size < WS_END) { fprintf(stderr, "kernel_launch: unexpected shapes n_in %d out %d ws %zu (need %zu)\n", n_in, out_size, ws_size, (size_t)WS_END); grid_blocks = -1; return; }
        int dev = 0, cus = 0, per_cu = 0;
        hipGetDevice(&dev);
        hipDeviceGetAttribute(&cus, hipDeviceAttributeMultiprocessorCount, dev);
        hipFuncSetAttribute((const void*)hymba_fwd, hipFuncAttributeMaxDynamicSharedMemorySize, (int)kDynLds);
        hipOccupancyMaxActiveBlocksPerMultiprocessor(&per_cu, (const void*)hymba_fwd, 512, kDynLds);
        if (per_cu < 1) per_cu = 1;
        grid_blocks = cus * per_cu;
        if (grid_blocks > 256) grid_blocks = 256;
    }
    if (grid_blocks < 0) return;
    Params p{};
    for (int i = 0; i < 39; ++i) p.in[i] = (const float*)d_in[i];
    p.out = (float*)d_out; p.ws = (unsigned char*)d_ws;
    if (hipMemsetAsync((unsigned char*)d_ws + OFF_CTR, 0, 1024, stream) != hipSuccess) { fprintf(stderr, "memset failed\n"); return; }
    void* args[] = {&p};
    hipError_t e = hipLaunchCooperativeKernel((const void*)hymba_fwd, dim3(grid_blocks), dim3(512), args, kDynLds, stream);
    if (e != hipSuccess) fprintf(stderr, "cooperative launch failed: %s (grid %d)\n", hipGetErrorString(e), grid_blocks);
}
```

```cpp
#include <hip/hip_runtime.h>
#include <hip/hip_cooperative_groups.h>
#include <cstdio>
namespace cg = cooperative_groups;


#define LAS __attribute__((address_space(3)))
typedef unsigned short bf16_t;
typedef short bf16x8 __attribute__((ext_vector_type(8)));
typedef float f32x4 __attribute__((ext_vector_type(4)));
typedef float f32x2 __attribute__((ext_vector_type(2)));
typedef unsigned u32x4 __attribute__((ext_vector_type(4)));
typedef unsigned u32x2 __attribute__((ext_vector_type(2)));

constexpr int S_ = 16384, D_ = 2048, FF_ = 5504, MEM_ = 256;
constexpr int RW_COLS = 3360, NSA_COLS = 2608, IN_COLS = 5968, IN_PAD = 6144;
constexpr int LORA_K = 384, LORA_N = 3072;
constexpr float EPS_ = 1e-6f;

constexpr size_t SZ_WGU = (size_t)2 * FF_ * D_ * 2, SZ_WD = (size_t)D_ * FF_ * 2;
constexpr size_t OFF_WGU = 0;
constexpr size_t OFF_WD = OFF_WGU + SZ_WGU;
constexpr size_t OFF_WIN = OFF_WD + SZ_WD;
constexpr size_t OFF_WOUT = OFF_WIN + (size_t)IN_PAD * D_ * 2;
constexpr size_t OFF_WMQ = OFF_WOUT + (size_t)D_ * D_ * 2;
constexpr size_t OFF_WMO = OFF_WMQ + (size_t)512 * D_ * 2;
constexpr size_t OFF_WMKV = OFF_WMO + (size_t)D_ * 512 * 2;
constexpr size_t OFF_WLORA = OFF_WMKV + (size_t)1024 * D_ * 2;
constexpr size_t OFF_WC1K = OFF_WLORA + (size_t)LORA_N * LORA_K * 2;
constexpr size_t OFF_WC1V = OFF_WC1K + (size_t)128 * 2048 * 2;
constexpr size_t OFF_WC2K = OFF_WC1V + (size_t)128 * 2048 * 2;
constexpr size_t OFF_WC2V = OFF_WC2K + (size_t)64 * 128 * 2;
constexpr size_t OFF_MEMN = OFF_WC2V + (size_t)64 * 128 * 2;
constexpr size_t OFF_KM = OFF_MEMN + (size_t)MEM_ * D_ * 2;
constexpr size_t OFF_VMT = OFF_KM + (size_t)MEM_ * 512 * 2;
constexpr size_t OFF_KCMP = OFF_VMT + (size_t)MEM_ * 512 * 2;
constexpr size_t OFF_VCMPT = OFF_KCMP + (size_t)4 * 1024 * 64 * 2;
constexpr size_t OFF_ROPE = OFF_VCMPT + (size_t)4 * 1024 * 64 * 2;
constexpr size_t OFF_CTR = OFF_ROPE + (size_t)S_ * 16 * 4;
constexpr size_t OFF_XN = ((OFF_CTR + 4096 + 1048575) / 1048576) * 1048576;
constexpr size_t OFF_ACT = OFF_XN + (size_t)S_ * D_ * 2;
constexpr size_t OFF_Y = OFF_ACT + (size_t)S_ * IN_PAD * 2;
constexpr size_t WS_END = OFF_Y + (size_t)S_ * D_ * 4;
constexpr size_t OFF_KSR = 0;
constexpr size_t OFF_KWR = OFF_KSR + (size_t)S_ * 256 * 2;
constexpr size_t OFF_VST = OFF_KWR + (size_t)S_ * 256 * 2;
constexpr size_t OFF_VWT = OFF_VST + (size_t)S_ * 256 * 2;
constexpr size_t OFF_XL = OFF_VWT + (size_t)S_ * 256 * 2;
constexpr size_t OFF_MIXEND = OFF_XL + (size_t)S_ * LORA_K * 2;
static_assert(OFF_MIXEND <= OFF_WIN, "mix temporaries overflow the FFN weight region");
constexpr size_t OFF_LORA = OFF_Y;
constexpr size_t OFF_YRAW = OFF_Y + (size_t)S_ * LORA_N * 2;
constexpr size_t OFF_QM = OFF_ACT;
constexpr size_t OFF_OM = OFF_ACT + (size_t)S_ * 512 * 2;

struct Params {
    const float* in[39];
    float* out;
    unsigned char* ws;
};

__device__ __forceinline__ float bf2f(bf16_t b) { return __uint_as_float(((unsigned)b) << 16); }
__device__ __forceinline__ unsigned pk2(float lo, float hi) { unsigned r; asm("v_cvt_pk_bf16_f32 %0, %1, %2" : "=v"(r) : "v"(lo), "v"(hi)); return r; }
__device__ __forceinline__ bf16_t f2bf(float f) { return (bf16_t)(pk2(f, 0.f) & 0xffffu); }
template <int CTRL> __device__ __forceinline__ float dppf(float x) { return __int_as_float(__builtin_amdgcn_update_dpp(0, __float_as_int(x), CTRL, 0xf, 0xf, false)); }
__device__ __forceinline__ float rowsum16(float x) { x += dppf<0x128>(x); x += dppf<0x124>(x); x += dppf<0x122>(x); x += dppf<0x121>(x); return x; }
__device__ __forceinline__ float rowmax16(float x) { x = fmaxf(x, dppf<0x128>(x)); x = fmaxf(x, dppf<0x124>(x)); x = fmaxf(x, dppf<0x122>(x)); x = fmaxf(x, dppf<0x121>(x)); return x; }
__device__ __forceinline__ float quad_allmax(float x) {
    auto r = __builtin_amdgcn_permlane32_swap(__float_as_uint(x), __float_as_uint(x), false, false); x = fmaxf(__uint_as_float(r[0]), __uint_as_float(r[1]));
    auto q = __builtin_amdgcn_permlane16_swap(__float_as_uint(x), __float_as_uint(x), false, false); return fmaxf(__uint_as_float(q[0]), __uint_as_float(q[1]));
}
__device__ __forceinline__ float quad_allsum(float x) {
    auto r = __builtin_amdgcn_permlane32_swap(__float_as_uint(x), __float_as_uint(x), false, false); x = __uint_as_float(r[0]) + __uint_as_float(r[1]);
    auto q = __builtin_amdgcn_permlane16_swap(__float_as_uint(x), __float_as_uint(x), false, false); return __uint_as_float(q[0]) + __uint_as_float(q[1]);
}
__device__ __forceinline__ float wave_sum(float v) { return quad_allsum(rowsum16(v)); }
__device__ __forceinline__ float wave_max(float v) { return quad_allmax(rowmax16(v)); }
__device__ __forceinline__ float sigmoidf_(float x) { return __builtin_amdgcn_rcpf(1.f + __expf(-x)); }
#define LDS_WAIT() asm volatile("s_waitcnt lgkmcnt(0)" ::: "memory")

namespace pg8 {
constexpr int BM = 256, BK = 64, HALF = 128, HTB = HALF * BK * 2, STAGE_BYTES = 8 * HTB, NXCD = 8, WGM = 4;
__host__ __device__ __forceinline__ int lds_byte(int r, int c) { const int st = (r >> 4) * 2 + (c >> 5), rr = r & 15, cc = c & 31, ob = rr * 64 + cc * 2; return st * 1024 + (ob ^ (((ob >> 9) & 1) << 5)); }
__host__ __device__ __forceinline__ void stage_rc(int b, int& R, int& C) { const int st = b / 1024, sb = b % 1024, swz = sb ^ (((sb >> 9) & 1) << 5); R = (st >> 1) * 16 + swz / 64; C = (st & 1) * 32 + (swz % 64) / 2; }
__host__ __device__ __forceinline__ int perm32(int rho) { const int n = rho >> 4, i = rho & 15; return 8 * (i >> 2) + 4 * n + (i & 3); }
struct Unit { int pm, pn; };
struct Gemm { const bf16_t* A; const bf16_t* Bt; int M, N, K; };
struct StaticOrder {
    int nM, nN, nwg, G, c;
    __device__ void init(int M, int N, int G_, int c_) { nM = M / BM; nN = N / BM; nwg = nM * nN; G = G_; c = c_; }
    __device__ bool next(int i, Unit& u) const {
        const long L = (long)i * G + c; if (L >= nwg) return false;
        int wgid = (int)L; { const int q = nwg / NXCD, r = nwg % NXCD, xcd = wgid % NXCD, off = wgid / NXCD; wgid = (xcd < r ? xcd * (q + 1) : r * (q + 1) + (xcd - r) * q) + off; }
        const int nig = WGM * nN, gid = wgid / nig, fm = gid * WGM, gsz = (nM - fm) < WGM ? (nM - fm) : WGM;
        u.pm = fm + ((wgid % nig) % gsz); u.pn = (wgid % nig) / gsz; return true;
    }
};

template <class Epi>
__device__ __forceinline__ void gemm_phase(LAS unsigned char* lds, const Gemm g, const StaticOrder& S, const Epi& E, const int wave_s) {
    int lane; asm volatile("v_mbcnt_lo_u32_b32 %0, -1, 0\n\tv_mbcnt_hi_u32_b32 %0, -1, %0" : "=v"(lane));
    const int wid = wave_s; const int tid = wid * 64 + lane; const int wr = wid >> 2, wc = wid & 3, fr = lane & 15, fq = lane >> 4;
    const int K = g.K, nt = K / BK;
    unsigned voffA[2], voffB[2];
#pragma unroll
    for (int i = 0; i < 2; ++i) { int R, C; stage_rc(tid * 16 + i * 8192, R, C); const int Rb = Epi::PERM ? ((R & ~31) + perm32(R & 31)) : R;
        voffA[i] = (unsigned)(R * K + C) * 2u; voffB[i] = (unsigned)(Rb * K + C) * 2u; }
    const size_t kstep = (size_t)(BK * 2);
    const size_t hstep = (size_t)HALF * K * 2;
    const size_t tstep = 2 * hstep;
    const unsigned ldsw = (unsigned)wid * 1024u;
    const int aoff = lds_byte(wr * 64 + fr, fq * 8), boff = lds_byte(wc * 32 + fr, fq * 8);
#define PG8_SA(b, h) (((b) * 2 + (h)) * HTB)
#define PG8_SB(b, h) ((4 + (b) * 2 + (h)) * HTB)
#define PG8_STAGE(bufoff, gbase, voff) do { _Pragma("unroll") for (int _i = 0; _i < 2; ++_i) \
        __builtin_amdgcn_global_load_lds((const unsigned*)((const char*)(gbase) + (voff)[_i]), (LAS unsigned*)(lds + (bufoff) + ldsw + _i * 8192), 16, 0, 0); } while (0)
#define PG8_LDA(dst, b, h) do { _Pragma("unroll") for (int m = 0; m < 4; ++m) _Pragma("unroll") for (int k = 0; k < 2; ++k) dst[m][k] = *(const LAS bf16x8*)(lds + PG8_SA(b, h) + aoff + m * 2048 + k * 1024); } while (0)
#define PG8_LDB(dst, b, h) do { _Pragma("unroll") for (int n = 0; n < 2; ++n) _Pragma("unroll") for (int k = 0; k < 2; ++k) dst[n][k] = *(const LAS bf16x8*)(lds + PG8_SB(b, h) + boff + n * 2048 + k * 1024); } while (0)
#define PG8_MMA(ai, bj, At, Bt) do { __builtin_amdgcn_s_setprio(1); _Pragma("unroll") for (int m = 0; m < 4; ++m) _Pragma("unroll") for (int n = 0; n < 2; ++n) _Pragma("unroll") for (int k = 0; k < 2; ++k) \
        acc[ai][bj][m][n] = __builtin_amdgcn_mfma_f32_16x16x32_bf16(Bt[n][k], At[m][k], acc[ai][bj][m][n], 0, 0, 0); __builtin_amdgcn_s_setprio(0); } while (0)
#define PG8_WAIT_V(n) asm volatile("s_waitcnt vmcnt(" #n ")" ::: "memory")
#define PG8_WAIT_L(n) asm volatile("s_waitcnt lgkmcnt(" #n ")" ::: "memory")
#define PG8_BAR __builtin_amdgcn_s_barrier()
#define PG8_SCHED __builtin_amdgcn_sched_barrier(0)
    Unit cur, nxt; int ui = 0;
    if (!S.next(0, cur)) return;
    f32x4 acc[2][2][4][2];
#pragma unroll
    for (int a = 0; a < 2; ++a)
#pragma unroll
        for (int b = 0; b < 2; ++b)
#pragma unroll
            for (int m = 0; m < 4; ++m)
#pragma unroll
                for (int n = 0; n < 2; ++n) acc[a][b][m][n] = (f32x4){0.f, 0.f, 0.f, 0.f};
    bf16x8 At[4][2], B0[2][2], B1[2][2];
    const char* cA = (const char*)g.A + (size_t)cur.pm * tstep; const char* cB = (const char*)g.Bt + (size_t)cur.pn * tstep;
    PG8_STAGE(PG8_SB(0, 0), cB, voffB); PG8_STAGE(PG8_SA(0, 0), cA, voffA); PG8_STAGE(PG8_SB(0, 1), cB + hstep, voffB); PG8_STAGE(PG8_SA(0, 1), cA + hstep, voffA);
    if (wr == 1) PG8_BAR;
    PG8_WAIT_V(4); PG8_BAR;
    PG8_STAGE(PG8_SB(1, 0), cB + kstep, voffB); PG8_STAGE(PG8_SA(1, 0), cA + kstep, voffA); PG8_STAGE(PG8_SB(1, 1), cB + hstep + kstep, voffB);
    PG8_WAIT_V(6); PG8_BAR;
    for (;;) {
        const bool has_next = S.next(ui + 1, nxt);
        const char* nA = has_next ? (const char*)g.A + (size_t)nxt.pm * tstep : cA; const char* nB = has_next ? (const char*)g.Bt + (size_t)nxt.pn * tstep : cB;
        for (int t = 0; t < nt; t += 2) {
            const bool last = (t == nt - 2);
            const char* a1 = cA + (size_t)(t + 1) * kstep;
            const char* a2 = last ? nA : cA + (size_t)(t + 2) * kstep; const char* b2 = last ? nB : cB + (size_t)(t + 2) * kstep;
            const char* a3 = a2 + kstep; const char* b3 = b2 + kstep;
            PG8_LDB(B0, 0, 0); PG8_SCHED; PG8_LDA(At, 0, 0); PG8_STAGE(PG8_SA(1, 1), a1 + hstep, voffA);
            PG8_WAIT_L(8); PG8_BAR; PG8_WAIT_L(0); PG8_MMA(0, 0, At, B0); PG8_BAR; PG8_SCHED;
            PG8_LDB(B1, 0, 1); PG8_STAGE(PG8_SB(0, 0), b2, voffB);
            PG8_BAR; PG8_WAIT_L(0); PG8_MMA(0, 1, At, B1); PG8_BAR;
            PG8_LDA(At, 0, 1); PG8_STAGE(PG8_SA(0, 0), a2, voffA);
            PG8_BAR; PG8_WAIT_L(0); PG8_MMA(1, 0, At, B0); PG8_BAR; PG8_SCHED;
            PG8_STAGE(PG8_SB(0, 1), b2 + hstep, voffB);
            PG8_WAIT_V(6); PG8_BAR; PG8_MMA(1, 1, At, B1); PG8_BAR;
            PG8_LDB(B0, 1, 0); PG8_SCHED; PG8_LDA(At, 1, 0); PG8_STAGE(PG8_SA(0, 1), a2 + hstep, voffA);
            PG8_WAIT_L(8); PG8_BAR; PG8_WAIT_L(0); PG8_MMA(0, 0, At, B0); PG8_BAR; PG8_SCHED;
            PG8_LDB(B1, 1, 1); PG8_STAGE(PG8_SB(1, 0), b3, voffB);
            PG8_BAR; PG8_WAIT_L(0); PG8_MMA(0, 1, At, B1); PG8_BAR;
            PG8_LDA(At, 1, 1); PG8_STAGE(PG8_SA(1, 0), a3, voffA);
            PG8_BAR; PG8_WAIT_L(0); PG8_MMA(1, 0, At, B0); PG8_BAR; PG8_SCHED;
            PG8_STAGE(PG8_SB(1, 1), b3 + hstep, voffB);
            PG8_WAIT_V(6); PG8_BAR; PG8_MMA(1, 1, At, B1); PG8_BAR;
        }
        E(acc, cur, wr, wc, fr, fq);
        if (!has_next) break;
#pragma unroll
        for (int a = 0; a < 2; ++a)
#pragma unroll
            for (int b = 0; b < 2; ++b)
#pragma unroll
                for (int m = 0; m < 4; ++m)
#pragma unroll
                    for (int n = 0; n < 2; ++n) acc[a][b][m][n] = (f32x4){0.f, 0.f, 0.f, 0.f};
        cur = nxt; cA = nA; cB = nB; ++ui;
    }
    PG8_WAIT_V(0);
    if (wr == 0) PG8_BAR;
    PG8_BAR;
#undef PG8_SA
#undef PG8_SB
#undef PG8_STAGE
#undef PG8_LDA
#undef PG8_LDB
#undef PG8_MMA
#undef PG8_WAIT_V
#undef PG8_WAIT_L
#undef PG8_BAR
#undef PG8_SCHED
}

struct EpiF32 {
    static constexpr bool PERM = false;
    float* C; int ldc;
    __device__ __forceinline__ void operator()(const f32x4 (&acc)[2][2][4][2], const Unit& u, int wr, int wc, int fr, int fq) const {
        const int row0 = u.pm * BM + wr * 64 + fr, col0 = u.pn * BM + wc * 32 + 4 * fq;
#pragma unroll
        for (int ai = 0; ai < 2; ++ai)
#pragma unroll
            for (int m = 0; m < 4; ++m) { float* rowp = C + (size_t)(row0 + ai * HALF + m * 16) * ldc + col0;
#pragma unroll
                for (int bj = 0; bj < 2; ++bj)
#pragma unroll
                    for (int n = 0; n < 2; ++n) *(f32x4*)(rowp + bj * HALF + n * 16) = acc[ai][bj][m][n]; }
    }
};
struct EpiBf16 {
    static constexpr bool PERM = true;
    bf16_t* O; int ldc;
    __device__ __forceinline__ void operator()(const f32x4 (&acc)[2][2][4][2], const Unit& u, int wr, int wc, int fr, int fq) const {
        const int row0 = u.pm * BM + wr * 64 + fr, col0 = u.pn * BM + wc * 32 + 8 * fq;
#pragma unroll
        for (int ai = 0; ai < 2; ++ai)
#pragma unroll
            for (int m = 0; m < 4; ++m) { bf16_t* rowp = O + (size_t)(row0 + ai * HALF + m * 16) * ldc + col0;
#pragma unroll
                for (int bj = 0; bj < 2; ++bj) { const f32x4 v0 = acc[ai][bj][m][0], v1 = acc[ai][bj][m][1];
                    u32x4 o; o.x = pk2(v0[0], v0[1]); o.y = pk2(v0[2], v0[3]); o.z = pk2(v1[0], v1[1]); o.w = pk2(v1[2], v1[3]);
                    *(u32x4*)(rowp + bj * HALF) = o; } }
    }
};
struct EpiSwiGLU {
    static constexpr bool PERM = true;
    bf16_t* O; int ldc;
    __device__ __forceinline__ void operator()(const f32x4 (&acc)[2][2][4][2], const Unit& u, int wr, int wc, int fr, int fq) const {
        const int row0 = u.pm * BM + wr * 64 + fr, col0 = u.pn * HALF + wc * 32 + 8 * fq;
#pragma unroll
        for (int ai = 0; ai < 2; ++ai)
#pragma unroll
            for (int m = 0; m < 4; ++m) { bf16_t* rowp = O + (size_t)(row0 + ai * HALF + m * 16) * ldc + col0;
                float v[8];
#pragma unroll
                for (int n = 0; n < 2; ++n)
#pragma unroll
                    for (int i = 0; i < 4; ++i) { const float gt = acc[ai][0][m][n][i], up = acc[ai][1][m][n][i]; v[n * 4 + i] = gt * sigmoidf_(gt) * up; }
                u32x4 o; o.x = pk2(v[0], v[1]); o.y = pk2(v[2], v[3]); o.z = pk2(v[4], v[5]); o.w = pk2(v[6], v[7]);
                *(u32x4*)rowp = o; }
    }
};
}

__device__ __forceinline__ void transpose_item(const float* __restrict__ W, int ldw, int ncols, int c0, int k0, bf16_t* dst, int ldd, LAS float* scr, int lane) {
    float tv[32]; const int cc = c0 + (lane & 31); const float* wp = W + (size_t)(k0 + (lane >> 5)) * ldw + cc;
#pragma unroll
    for (int i = 0; i < 32; ++i) tv[i] = (cc < ncols) ? wp[(size_t)(2 * i) * ldw] : 0.f;
#pragma unroll
    for (int i = 0; i < 32; ++i) scr[(2 * i + (lane >> 5)) * 33 + (lane & 31)] = tv[i];
    LDS_WAIT();
    const int c = lane & 7;
#pragma unroll
    for (int j = 0; j < 4; ++j) { const int n = (lane >> 3) + 8 * j; const LAS float* s = scr + (8 * c) * 33 + n;
        u32x4 o; o.x = pk2(s[0 * 33], s[1 * 33]); o.y = pk2(s[2 * 33], s[3 * 33]); o.z = pk2(s[4 * 33], s[5 * 33]); o.w = pk2(s[6 * 33], s[7 * 33]);
        *(u32x4*)(dst + (size_t)n * ldd + k0 + 8 * c) = o; }
    LDS_WAIT();
}
__device__ __forceinline__ void conv_plain(const float* W, int K, int N, int Npad, bf16_t* dst, LAS float* scr, int lane, int gw, int NGW) {
    const int nblk = Npad / 32, items = (K / 64) * nblk;
    for (int it = gw; it < items; it += NGW) { const int kb = it / nblk, nb = it % nblk;
        transpose_item(W, N, N, nb * 32, kb * 64, dst + (size_t)nb * 32 * K, K, scr, lane); }
}
__device__ __forceinline__ void conv_gateup(const float* Wg, const float* Wu, bf16_t* dst, LAS float* scr, int lane, int gw, int NGW) {
    const int nblk = (2 * FF_) / 32, items = (D_ / 64) * nblk;
    for (int it = gw; it < items; it += NGW) { const int kb = it / nblk, nb = it % nblk; const int n0 = nb * 32, tile = n0 >> 8, w = n0 & 255;
        const float* W = (w < 128) ? Wg : Wu; const int c0 = tile * 128 + (w & 127);
        transpose_item(W, FF_, FF_, c0, kb * 64, dst + (size_t)n0 * D_, D_, scr, lane); }
}
__device__ __forceinline__ void rms_row_to_bf16(const float* xrow, const float* g, bf16_t* orow, int lane) {
    const f32x4* xr = (const f32x4*)xrow + lane; const f32x4* gr = (const f32x4*)g + lane;
    f32x4 v[8]; float s = 0.f;
#pragma unroll
    for (int j = 0; j < 8; ++j) { v[j] = xr[64 * j]; s += (v[j].x * v[j].x + v[j].y * v[j].y) + (v[j].z * v[j].z + v[j].w * v[j].w); }
    const float rs = rsqrtf(wave_sum(s) * (1.f / D_) + EPS_);
    u32x2* o8 = (u32x2*)orow + lane;
#pragma unroll
    for (int j = 0; j < 8; ++j) { const f32x4 gg = gr[64 * j]; u32x2 o; o.x = pk2(v[j].x * rs * gg.x, v[j].y * rs * gg.y); o.y = pk2(v[j].z * rs * gg.z, v[j].w * rs * gg.w); o8[64 * j] = o; }
}
__device__ __forceinline__ void norm_phase(const float* hin, const bf16_t* Y, float coef, const float* g_post, float* hout, const float* g_pre, bf16_t* xn, int lane, int gw, int NGW) {
    for (int row = gw; row < S_; row += NGW) {
        const u32x2* yr = (const u32x2*)(Y + (size_t)row * D_) + lane; const f32x4* hr = (const f32x4*)(hin + (size_t)row * D_) + lane;
        const f32x4* gp = (const f32x4*)g_post + lane;
        f32x4 v[8]; float s = 0.f;
#pragma unroll
        for (int j = 0; j < 8; ++j) { const u32x2 w = yr[64 * j]; v[j].x = __uint_as_float(w.x << 16); v[j].y = __uint_as_float(w.x & 0xffff0000u); v[j].z = __uint_as_float(w.y << 16); v[j].w = __uint_as_float(w.y & 0xffff0000u);
            s += (v[j].x * v[j].x + v[j].y * v[j].y) + (v[j].z * v[j].z + v[j].w * v[j].w); }
        const float rs = rsqrtf(wave_sum(s) * (1.f / D_) + EPS_) * coef;
        f32x4* ho = (f32x4*)(hout + (size_t)row * D_) + lane;
        float s2 = 0.f;
#pragma unroll
        for (int j = 0; j < 8; ++j) { const f32x4 gg = gp[64 * j]; const f32x4 h = hr[64 * j];
            v[j].x = h.x + v[j].x * rs * gg.x; v[j].y = h.y + v[j].y * rs * gg.y; v[j].z = h.z + v[j].z * rs * gg.z; v[j].w = h.w + v[j].w * rs * gg.w;
            ho[64 * j] = v[j]; s2 += (v[j].x * v[j].x + v[j].y * v[j].y) + (v[j].z * v[j].z + v[j].w * v[j].w); }
        if (g_pre) {
            const float rs2 = rsqrtf(wave_sum(s2) * (1.f / D_) + EPS_);
            const f32x4* gq = (const f32x4*)g_pre + lane; u32x2* o8 = (u32x2*)(xn + (size_t)row * D_) + lane;
#pragma unroll
            for (int j = 0; j < 8; ++j) { const f32x4 gg = gq[64 * j]; u32x2 o; o.x = pk2(v[j].x * rs2 * gg.x, v[j].y * rs2 * gg.y); o.y = pk2(v[j].z * rs2 * gg.z, v[j].w * rs2 * gg.w); o8[64 * j] = o; }
        }
    }
}

__device__ __forceinline__ f32x4 wave_tile_gemm(const bf16_t* A, int lda, const bf16_t* Bt, int ldb, int K, int lane) {
    const bf16_t* ap = A + (size_t)(lane & 15) * lda + (lane >> 4) * 8; const bf16_t* bp = Bt + (size_t)(lane & 15) * ldb + (lane >> 4) * 8;
    f32x4 acc = {0.f, 0.f, 0.f, 0.f};
#pragma unroll 4
    for (int k = 0; k < K; k += 32) { const bf16x8 a = *(const bf16x8*)(ap + k), b = *(const bf16x8*)(bp + k); acc = __builtin_amdgcn_mfma_f32_16x16x32_bf16(a, b, acc, 0, 0, 0); }
    return acc;
}


__device__ __forceinline__ float tanhf_(float x) { const float e = __expf(2.f * x); return 1.f - 2.f * __builtin_amdgcn_rcpf(e + 1.f); }
__device__ __forceinline__ float gelu_tanh(float x) { return 0.5f * x * (1.f + tanhf_(0.7978845608f * (x + 0.044715f * x * x * x))); }
__device__ __forceinline__ bf16x8 pack8(const f32x4 a, const f32x4 b) { u32x4 o; o.x = pk2(a[0], a[1]); o.y = pk2(a[2], a[3]); o.z = pk2(b[0], b[1]); o.w = pk2(b[2], b[3]); return __builtin_bit_cast(bf16x8, o); }
__device__ __forceinline__ bf16x8 ld2x4(const bf16_t* p0, const bf16_t* p1) { const u32x2 a = *(const u32x2*)p0, b = *(const u32x2*)p1; u32x4 o; o.x = a.x; o.y = a.y; o.z = b.x; o.w = b.y; return __builtin_bit_cast(bf16x8, o); }
__device__ __forceinline__ float shiftv(const bf16_t* F, int t, int col, float mu) { const float f = bf2f(F[(size_t)t * IN_PAD + col]); const float fp = t > 0 ? bf2f(F[(size_t)(t - 1) * IN_PAD + col]) : 0.f; return f + mu * (fp - f); }

constexpr int C_R = 0, C_K = 1024, C_V = 2048, C_WD = 3072, C_Q = 3360, C_KC = 4384, C_VC = 4640, C_KS = 4896, C_VS = 5152, C_KW = 5408, C_VW = 5664, C_GL = 5920;

struct EpiLora {
    static constexpr bool PERM = true;
    bf16_t* O; const float* w0; const float* a0;
    __device__ __forceinline__ void operator()(const f32x4 (&acc)[2][2][4][2], const pg8::Unit& u, int wr, int wc, int fr, int fq) const {
        { int ln; asm volatile("v_mbcnt_lo_u32_b32 %0, -1, 0\n\tv_mbcnt_hi_u32_b32 %0, -1, %0" : "=v"(ln)); fr = ln & 15; fq = ln >> 4; }
        const int row0 = u.pm * 256 + wr * 64 + fr, col0 = u.pn * 256 + wc * 32 + 8 * fq; const int type = u.pn >> 2;
#pragma unroll
        for (int ai = 0; ai < 2; ++ai)
#pragma unroll
            for (int m = 0; m < 4; ++m) { bf16_t* rowp = O + (size_t)(row0 + ai * 128 + m * 16) * LORA_N + col0;
#pragma unroll
                for (int bj = 0; bj < 2; ++bj) { float v[8];
#pragma unroll
                    for (int n = 0; n < 2; ++n)
#pragma unroll
                        for (int i = 0; i < 4; ++i) { float x = acc[ai][bj][m][n][i]; const int c = (col0 + bj * 128 + n * 4 + i) & 1023;
                            if (type == 0) x = 0.60653066f * sigmoidf_(x + w0[c]); else if (type == 1) x = sigmoidf_(x + a0[c]);
                            v[n * 4 + i] = x; }
                    u32x4 o; o.x = pk2(v[0], v[1]); o.y = pk2(v[2], v[3]); o.z = pk2(v[4], v[5]); o.w = pk2(v[6], v[7]);
                    *(u32x4*)(rowp + bj * 128) = o; } }
    }
};

__device__ __forceinline__ void compress_task(const Params& p, unsigned char* ws, int task, int lane) {
    const int which = task >> 8, g = (task >> 6) & 3, n0 = (task & 63) * 16;
    const bf16_t* FE = (const bf16_t*)(ws + OFF_ACT);
    const bf16_t* W1T = (const bf16_t*)(ws + (which ? OFF_WC1V : OFF_WC1K));
    const bf16_t* W2T = (const bf16_t*)(ws + (which ? OFF_WC2V : OFF_WC2K));
    const float* pe = which ? p.in[23] : p.in[20];
    const int cb = (which ? C_VC : C_KC) + g * 64;
    const int col = lane & 15, quad = lane >> 4;
    int nn = n0 + col; if (nn > 1022) nn = 1022;
    f32x4 acc[8];
#pragma unroll
    for (int i = 0; i < 8; ++i) acc[i] = (f32x4){0.f, 0.f, 0.f, 0.f};
    for (int kt = 0; kt < 64; ++kt) {
        const int pp = kt >> 1, d = (kt & 1) * 32 + quad * 8;
        const bf16x8 xf = *(const bf16x8*)(FE + (size_t)(16 * nn + pp) * IN_PAD + cb + d);
        const f32x4 pa = *(const f32x4*)(pe + pp * 64 + d), pb = *(const f32x4*)(pe + pp * 64 + d + 4);
        const bf16x8 pf = pack8(pa, pb);
#pragma unroll
        for (int ct = 0; ct < 8; ++ct) { const bf16x8 wf = *(const bf16x8*)(W1T + (size_t)(ct * 16 + col) * 2048 + kt * 32 + quad * 8);
            acc[ct] = __builtin_amdgcn_mfma_f32_16x16x32_bf16(wf, xf, acc[ct], 0, 0, 0);
            acc[ct] = __builtin_amdgcn_mfma_f32_16x16x32_bf16(wf, pf, acc[ct], 0, 0, 0); }
    }
#pragma unroll
    for (int ct = 0; ct < 8; ++ct)
#pragma unroll
        for (int r = 0; r < 4; ++r) acc[ct][r] = gelu_tanh(acc[ct][r]);
    f32x4 o[4];
#pragma unroll
    for (int et = 0; et < 4; ++et) { o[et] = (f32x4){0.f, 0.f, 0.f, 0.f};
#pragma unroll
        for (int i = 0; i < 4; ++i) { const bf16x8 hf = pack8(acc[2 * i], acc[2 * i + 1]);
            const bf16_t* wr_ = W2T + (size_t)(et * 16 + col) * 128 + 32 * i + quad * 4;
            const bf16x8 wf = ld2x4(wr_, wr_ + 16);
            o[et] = __builtin_amdgcn_mfma_f32_16x16x32_bf16(wf, hf, o[et], 0, 0, 0); } }
    const int n = n0 + col;
    if (which == 0) { bf16_t* K = (bf16_t*)(ws + OFF_KCMP) + ((size_t)g * 64 + (n >> 4)) * 1024 + (n & 15) * 32;
#pragma unroll
        for (int et = 0; et < 4; ++et) { u32x2 v; v.x = pk2(o[et][0], o[et][1]); v.y = pk2(o[et][2], o[et][3]); *(u32x2*)(K + (et >> 1) * 512 + (et & 1) * 16 + quad * 4) = v; }
    } else { bf16_t* V = (bf16_t*)(ws + OFF_VCMPT) + ((size_t)g * 32 + (n >> 5)) * 2048 + ((n & 15) >> 2) * 8 + ((n >> 4) & 1) * 4 + (n & 3);
#pragma unroll
        for (int et = 0; et < 4; ++et)
#pragma unroll
            for (int r = 0; r < 4; ++r) V[et * 512 + (quad * 4 + r) * 32] = f2bf(o[et][r]);
    }
}

constexpr int SCAN_T = 32, SCAN_BUF_F = 5 * SCAN_T * 64 + SCAN_T * 16;
struct ScanRaw { float rr[9], kr[9], vr[9], uu[8], aa[8]; };
__device__ __forceinline__ void scan_fetch(ScanRaw& x, unsigned char* ws, int c, int head, int rbase, int lw, int lane) {
    const bf16_t* FE = (const bf16_t*)(ws + OFF_ACT); const bf16_t* LO = (const bf16_t*)(ws + OFF_LORA);
    const int cr = head * 64 + lane, vcol = C_V + head * 64 + rbase + (lane & 15), ta = c * SCAN_T + lw * 8;
#pragma unroll
    for (int i = 0; i < 9; ++i) { const int t = ta - 1 + i;
        if (t >= 0) { x.rr[i] = bf2f(FE[(size_t)t * IN_PAD + C_R + cr]); x.kr[i] = bf2f(FE[(size_t)t * IN_PAD + C_K + cr]); x.vr[i] = bf2f(FE[(size_t)t * IN_PAD + vcol]); }
        else { x.rr[i] = 0.f; x.kr[i] = 0.f; x.vr[i] = 0.f; } }
#pragma unroll
    for (int i = 0; i < 8; ++i) { const int t = ta + i; x.uu[i] = bf2f(LO[(size_t)t * LORA_N + cr]); x.aa[i] = bf2f(LO[(size_t)t * LORA_N + 1024 + cr]); }
}
__device__ __forceinline__ void scan_emit(const ScanRaw& x, LAS float* buf, float mu_r, float mu_k, float mu_v, float kkw, float kaw, int lw, int lane) {
#pragma unroll
    for (int i = 0; i < 8; ++i) { const int tt = lw * 8 + i;
        const float r = x.rr[i + 1] + mu_r * (x.rr[i] - x.rr[i + 1]), k = x.kr[i + 1] + mu_k * (x.kr[i] - x.kr[i + 1]), v = x.vr[i + 1] + mu_v * (x.vr[i] - x.vr[i + 1]);
        const float a = x.aa[i], w = __expf(-x.uu[i]);
        const float kx = k * kkw; const float ss = wave_sum(kx * kx); const float kkn = kx / fmaxf(sqrtf(ss), 1e-12f);
        buf[0 * SCAN_T * 64 + tt * 64 + lane] = w;
        buf[1 * SCAN_T * 64 + tt * 64 + lane] = -kkn;
        buf[2 * SCAN_T * 64 + tt * 64 + lane] = kkn * a;
        buf[3 * SCAN_T * 64 + tt * 64 + lane] = k * (1.f + (a - 1.f) * kaw);
        buf[4 * SCAN_T * 64 + tt * 64 + lane] = r;
        if (lane < 16) buf[5 * SCAN_T * 64 + tt * 16 + lane] = v; }
}
__device__ __forceinline__ void scan_step(float& s0, float& s1, float& s2, float& s3, const f32x4 NK, const f32x4 W, const f32x4 B, const f32x4 R,
                                          float t0, float t1, float t2, float t3, float& yp, float& yc) {
    float sa, tmp;
    asm volatile(
        "v_mul_f32 %[sa], %[s0], %[n0]\n\t"
        "v_mul_f32 %[tmp], %[s2], %[n2]\n\t"
        "v_fmac_f32 %[sa], %[s1], %[n1]\n\t"
        "v_fmac_f32 %[tmp], %[s3], %[n3]\n\t"
        "v_add_f32 %[sa], %[sa], %[tmp]\n\t"
        "s_nop 1\n\t"
        "v_add_f32_dpp %[sa], %[sa], %[sa] row_ror:8 row_mask:0xf bank_mask:0xf\n\t"
        "v_add_f32_dpp %[yp], %[yp], %[yp] row_ror:8 row_mask:0xf bank_mask:0xf\n\t"
        "s_nop 0\n\t"
        "v_add_f32_dpp %[sa], %[sa], %[sa] row_ror:4 row_mask:0xf bank_mask:0xf\n\t"
        "v_add_f32_dpp %[yp], %[yp], %[yp] row_ror:4 row_mask:0xf bank_mask:0xf\n\t"
        "s_nop 0\n\t"
        "v_add_f32_dpp %[sa], %[sa], %[sa] row_ror:2 row_mask:0xf bank_mask:0xf\n\t"
        "v_add_f32_dpp %[yp], %[yp], %[yp] row_ror:2 row_mask:0xf bank_mask:0xf\n\t"
        "s_nop 0\n\t"
        "v_add_f32_dpp %[sa], %[sa], %[sa] row_ror:1 row_mask:0xf bank_mask:0xf\n\t"
        "v_add_f32_dpp %[yp], %[yp], %[yp] row_ror:1 row_mask:0xf bank_mask:0xf\n\t"
        "v_fmac_f32 %[t0], %[sa], %[b0]\n\t"
        "v_fmac_f32 %[t1], %[sa], %[b1]\n\t"
        "v_fmac_f32 %[t2], %[sa], %[b2]\n\t"
        "v_fmac_f32 %[t3], %[sa], %[b3]\n\t"
        "v_fma_f32 %[s0], %[s0], %[w0], %[t0]\n\t"
        "v_fma_f32 %[s1], %[s1], %[w1], %[t1]\n\t"
        "v_fma_f32 %[s2], %[s2], %[w2], %[t2]\n\t"
        "v_fma_f32 %[s3], %[s3], %[w3], %[t3]\n\t"
        "v_mul_f32 %[yc], %[s0], %[r0]\n\t"
        "v_mul_f32 %[tmp], %[s2], %[r2]\n\t"
        "v_fmac_f32 %[yc], %[s1], %[r1]\n\t"
        "v_fmac_f32 %[tmp], %[s3], %[r3]\n\t"
        "v_add_f32 %[yc], %[yc], %[tmp]\n\t"
        : [s0] "+v"(s0), [s1] "+v"(s1), [s2] "+v"(s2), [s3] "+v"(s3), [t0] "+v"(t0), [t1] "+v"(t1), [t2] "+v"(t2), [t3] "+v"(t3),
          [yp] "+v"(yp), [yc] "=&v"(yc), [sa] "=&v"(sa), [tmp] "=&v"(tmp)
        : [n0] "v"(NK.x), [n1] "v"(NK.y), [n2] "v"(NK.z), [n3] "v"(NK.w), [w0] "v"(W.x), [w1] "v"(W.y), [w2] "v"(W.z), [w3] "v"(W.w),
          [b0] "v"(B.x), [b1] "v"(B.y), [b2] "v"(B.z), [b3] "v"(B.w), [r0] "v"(R.x), [r1] "v"(R.y), [r2] "v"(R.z), [r3] "v"(R.w));
}
__device__ __forceinline__ f32x2 scan_dot2(const f32x2 sA, const f32x2 sB, const f32x2 xA, const f32x2 xB) {
    f32x2 t;
    asm volatile("v_pk_mul_f32 %[t], %[sA], %[xA]\n\tv_pk_fma_f32 %[t], %[sB], %[xB], %[t]\n\t" : [t] "=&v"(t) : [sA] "v"(sA), [sB] "v"(sB), [xA] "v"(xA), [xB] "v"(xB));
    return t;
}
__device__ __forceinline__ void scan_reduce2(float& sa, float& yp) {
    asm volatile(
        "s_nop 1\n\t"
        "v_add_f32_dpp %[sa], %[sa], %[sa] row_ror:8 row_mask:0xf bank_mask:0xf\n\t"
        "v_add_f32_dpp %[yp], %[yp], %[yp] row_ror:8 row_mask:0xf bank_mask:0xf\n\t"
        "s_nop 0\n\t"
        "v_add_f32_dpp %[sa], %[sa], %[sa] row_ror:4 row_mask:0xf bank_mask:0xf\n\t"
        "v_add_f32_dpp %[yp], %[yp], %[yp] row_ror:4 row_mask:0xf bank_mask:0xf\n\t"
        "s_nop 0\n\t"
        "v_add_f32_dpp %[sa], %[sa], %[sa] row_ror:2 row_mask:0xf bank_mask:0xf\n\t"
        "v_add_f32_dpp %[yp], %[yp], %[yp] row_ror:2 row_mask:0xf bank_mask:0xf\n\t"
        "s_nop 0\n\t"
        "v_add_f32_dpp %[sa], %[sa], %[sa] row_ror:1 row_mask:0xf bank_mask:0xf\n\t"
        "v_add_f32_dpp %[yp], %[yp], %[yp] row_ror:1 row_mask:0xf bank_mask:0xf\n\t"
        "s_nop 1\n\t"
        : [sa] "+v"(sa), [yp] "+v"(yp));
}
__device__ __forceinline__ void scan_update2(f32x2& sA, f32x2& sB, const f32x2 wA, const f32x2 wB, const f32x2 bA, const f32x2 bB, const f32x2 kA, const f32x2 kB, const f32x2 sa2, const f32x2 vv2) {
    f32x2 uA, uB;
    asm volatile(
        "v_pk_mul_f32 %[uA], %[kA], %[vv2] op_sel_hi:[1,0]\n\t"
        "v_pk_mul_f32 %[uB], %[kB], %[vv2] op_sel_hi:[1,0]\n\t"
        "v_pk_fma_f32 %[uA], %[bA], %[sa2], %[uA] op_sel_hi:[1,0,1]\n\t"
        "v_pk_fma_f32 %[uB], %[bB], %[sa2], %[uB] op_sel_hi:[1,0,1]\n\t"
        "v_pk_fma_f32 %[sA], %[sA], %[wA], %[uA]\n\t"
        "v_pk_fma_f32 %[sB], %[sB], %[wB], %[uB]\n\t"
        : [sA] "+v"(sA), [sB] "+v"(sB), [uA] "=&v"(uA), [uB] "=&v"(uB)
        : [wA] "v"(wA), [wB] "v"(wB), [bA] "v"(bA), [bB] "v"(bB), [kA] "v"(kA), [kB] "v"(kB), [sa2] "v"(sa2), [vv2] "v"(vv2));
}
#define SCAN_BAR() do { asm volatile("s_waitcnt lgkmcnt(0)" ::: "memory"); __builtin_amdgcn_s_barrier(); asm volatile("" ::: "memory"); } while (0)
__device__ __forceinline__ void rwkv_scan_block(const Params& p, unsigned char* ws, LAS unsigned char* lds, int sb, int tid) {
    const int lane = tid & 63, wave = tid >> 6; const int head = sb >> 2, rbase = (sb & 3) * 16;
    LAS float* buf0 = (LAS float*)lds; LAS float* buf1 = buf0 + SCAN_BUF_F;
    bf16_t* YR = (bf16_t*)(ws + OFF_YRAW);
    const int cg_ = lane & 15, rl = (wave & 3) * 4 + (lane >> 4);
    constexpr int NCH = S_ / SCAN_T;
    if (wave >= 4) {
        const int lw = wave - 4; const int cr = head * 64 + lane, vcol = C_V + head * 64 + rbase + (lane & 15);
        const float mu_r = p.in[9][C_R + cr], mu_k = p.in[9][C_K + cr], mu_v = p.in[9][vcol], kkw = p.in[15][cr], kaw = p.in[16][cr];
        ScanRaw x; scan_fetch(x, ws, 0, head, rbase, lw, lane); scan_emit(x, buf0, mu_r, mu_k, mu_v, kkw, kaw, lw, lane); scan_fetch(x, ws, 1, head, rbase, lw, lane);
        SCAN_BAR();
        for (int c = 0; c < NCH; ++c) {
            if (c + 1 < NCH) scan_emit(x, (c & 1) ? buf0 : buf1, mu_r, mu_k, mu_v, kkw, kaw, lw, lane);
            if (c + 2 < NCH) scan_fetch(x, ws, c + 2, head, rbase, lw, lane);
            SCAN_BAR(); }
    } else {
        f32x2 sA = {0.f, 0.f}, sB = {0.f, 0.f};
        SCAN_BAR();
        for (int c = 0; c < NCH; ++c) {
            LAS float* cb = ((c & 1) ? buf1 : buf0) + cg_ * 4; LAS float* vb = ((c & 1) ? buf1 : buf0) + 5 * SCAN_T * 64 + rl;
#pragma unroll
            for (int hh = 0; hh < SCAN_T / 16; ++hh) {
                float ykeep = 0.f, yp = 0.f, yc = 0.f;
                f32x4 W = *(const LAS f32x4*)(cb + 0 * SCAN_T * 64 + hh * 1024), NK = *(const LAS f32x4*)(cb + 1 * SCAN_T * 64 + hh * 1024), B = *(const LAS f32x4*)(cb + 2 * SCAN_T * 64 + hh * 1024),
                      KP = *(const LAS f32x4*)(cb + 3 * SCAN_T * 64 + hh * 1024), R = *(const LAS f32x4*)(cb + 4 * SCAN_T * 64 + hh * 1024); float vv = vb[hh * 256];
#pragma unroll
                for (int ti = 0; ti < 16; ++ti) {
                    const int tn = hh * 16 + (ti < 15 ? ti + 1 : ti);
                    const f32x4 Wn = *(const LAS f32x4*)(cb + 0 * SCAN_T * 64 + tn * 64), NKn = *(const LAS f32x4*)(cb + 1 * SCAN_T * 64 + tn * 64), Bn = *(const LAS f32x4*)(cb + 2 * SCAN_T * 64 + tn * 64),
                                KPn = *(const LAS f32x4*)(cb + 3 * SCAN_T * 64 + tn * 64), Rn = *(const LAS f32x4*)(cb + 4 * SCAN_T * 64 + tn * 64); const float vn = vb[tn * 16];
                    const f32x2 d = scan_dot2(sA, sB, (f32x2){NK.x, NK.y}, (f32x2){NK.z, NK.w});
                    float sa = d.x + d.y; yp = yc;
                    scan_reduce2(sa, yp);
                    f32x2 sa2; sa2.x = sa; sa2.y = sa; f32x2 vv2; vv2.x = vv; vv2.y = vv;
                    scan_update2(sA, sB, (f32x2){W.x, W.y}, (f32x2){W.z, W.w}, (f32x2){B.x, B.y}, (f32x2){B.z, B.w}, (f32x2){KP.x, KP.y}, (f32x2){KP.z, KP.w}, sa2, vv2);
                    const f32x2 e = scan_dot2(sA, sB, (f32x2){R.x, R.y}, (f32x2){R.z, R.w});
                    yc = e.x + e.y;
                    if (ti >= 1) ykeep = (cg_ == ti - 1) ? yp : ykeep;
                    W = Wn; NK = NKn; B = Bn; KP = KPn; R = Rn; vv = vn;
                }
                const float y15 = rowsum16(yc);
                ykeep = (cg_ == 15) ? y15 : ykeep;
                YR[(size_t)(c * SCAN_T + hh * 16 + cg_) * 1024 + head * 64 + rbase + rl] = f2bf(ykeep);
            }
            SCAN_BAR(); }
    }
}

constexpr float QK_SCALE2 = 0.125f * 1.4426950408889634f;
struct Flash { float m, l; f32x4 o[4]; };
__device__ __forceinline__ void flash_init(Flash& f) { f.m = -1e30f; f.l = 0.f;
#pragma unroll
    for (int i = 0; i < 4; ++i) f.o[i] = (f32x4){0.f, 0.f, 0.f, 0.f}; }
struct KV64 { bf16x8 k[4][2]; bf16x8 v[2][4]; };
__device__ __forceinline__ void load_kv64(KV64& x, const bf16_t* Kp, const bf16_t* Vt, int kb, int col, int quad) {
#pragma unroll
    for (int a = 0; a < 4; ++a) { const bf16_t* kr = Kp + (size_t)((kb >> 4) + a) * 1024 + col * 32 + quad * 8; x.k[a][0] = *(const bf16x8*)kr; x.k[a][1] = *(const bf16x8*)(kr + 512); }
#pragma unroll
    for (int h = 0; h < 2; ++h)
#pragma unroll
        for (int dt = 0; dt < 4; ++dt) { const bf16_t* vr = Vt + (size_t)((kb >> 5) + h) * 2048 + dt * 512 + col * 32 + quad * 8; x.v[h][dt] = *(const bf16x8*)vr; }
}
__device__ __forceinline__ void flash_block64(Flash& f, const bf16x8 (&q)[2], const KV64& x, int kb, int lo, int hi, bool masked, int quad) {
    f32x4 s[4];
#pragma unroll
    for (int a = 0; a < 4; ++a) { s[a] = (f32x4){0.f, 0.f, 0.f, 0.f};
#pragma unroll
        for (int ks = 0; ks < 2; ++ks) s[a] = __builtin_amdgcn_mfma_f32_16x16x32_bf16(x.k[a][ks], q[ks], s[a], 0, 0, 0); }
    if (masked) {
#pragma unroll
        for (int a = 0; a < 4; ++a)
#pragma unroll
            for (int r = 0; r < 4; ++r) { const int key = kb + 16 * a + quad * 4 + r; s[a][r] = (key >= lo && key <= hi) ? s[a][r] : -1e30f; }
    }
    float mx = fmaxf(fmaxf(fmaxf(s[0][0], s[0][1]), fmaxf(s[0][2], s[0][3])), fmaxf(fmaxf(s[1][0], s[1][1]), fmaxf(s[1][2], s[1][3])));
    mx = fmaxf(mx, fmaxf(fmaxf(fmaxf(s[2][0], s[2][1]), fmaxf(s[2][2], s[2][3])), fmaxf(fmaxf(s[3][0], s[3][1]), fmaxf(s[3][2], s[3][3]))));
    mx = quad_allmax(mx) * QK_SCALE2;
    const float mn = fmaxf(f.m, mx);
    if (__ballot(mn != f.m) != 0ull) {
        const float alpha = __builtin_amdgcn_exp2f(f.m - mn); f.m = mn; f.l *= alpha;
#pragma unroll
        for (int dt = 0; dt < 4; ++dt) f.o[dt] *= alpha; }
    float ps = 0.f;
    if (masked) {
#pragma unroll
        for (int a = 0; a < 4; ++a)
#pragma unroll
            for (int r = 0; r < 4; ++r) { const float pv = s[a][r] > -1e29f ? __builtin_amdgcn_exp2f(__builtin_fmaf(s[a][r], QK_SCALE2, -mn)) : 0.f; s[a][r] = pv; ps += pv; }
    } else {
#pragma unroll
        for (int a = 0; a < 4; ++a)
#pragma unroll
            for (int r = 0; r < 4; ++r) { const float pv = __builtin_amdgcn_exp2f(__builtin_fmaf(s[a][r], QK_SCALE2, -mn)); s[a][r] = pv; ps += pv; }
    }
    f.l += ps;
    const bf16x8 p0 = pack8(s[0], s[1]), p1 = pack8(s[2], s[3]);
#pragma unroll
    for (int dt = 0; dt < 4; ++dt) { f.o[dt] = __builtin_amdgcn_mfma_f32_16x16x32_bf16(x.v[0][dt], p0, f.o[dt], 0, 0, 0); f.o[dt] = __builtin_amdgcn_mfma_f32_16x16x32_bf16(x.v[1][dt], p1, f.o[dt], 0, 0, 0); }
}
__device__ __forceinline__ void flash_block64v(Flash& f, const bf16x8 (&q)[2], const KV64& x, bool valid) {
    f32x4 s[4];
#pragma unroll
    for (int a = 0; a < 4; ++a) { s[a] = (f32x4){0.f, 0.f, 0.f, 0.f};
#pragma unroll
        for (int ks = 0; ks < 2; ++ks) s[a] = __builtin_amdgcn_mfma_f32_16x16x32_bf16(x.k[a][ks], q[ks], s[a], 0, 0, 0); }
    float mx = fmaxf(fmaxf(fmaxf(s[0][0], s[0][1]), fmaxf(s[0][2], s[0][3])), fmaxf(fmaxf(s[1][0], s[1][1]), fmaxf(s[1][2], s[1][3])));
    mx = fmaxf(mx, fmaxf(fmaxf(fmaxf(s[2][0], s[2][1]), fmaxf(s[2][2], s[2][3])), fmaxf(fmaxf(s[3][0], s[3][1]), fmaxf(s[3][2], s[3][3]))));
    mx = valid ? quad_allmax(mx) * QK_SCALE2 : f.m;
    const float mn = fmaxf(f.m, mx);
    if (__ballot(mn != f.m) != 0ull) {
        const float alpha = __builtin_amdgcn_exp2f(f.m - mn); f.m = mn; f.l *= alpha;
#pragma unroll
        for (int dt = 0; dt < 4; ++dt) f.o[dt] *= alpha; }
    float ps = 0.f;
#pragma unroll
    for (int a = 0; a < 4; ++a)
#pragma unroll
        for (int r = 0; r < 4; ++r) { const float pv = __builtin_amdgcn_exp2f(__builtin_fmaf(s[a][r], QK_SCALE2, -mn)); s[a][r] = pv; ps += pv; }
    f.l += valid ? ps : 0.f;
    const unsigned vm = valid ? 0xffffffffu : 0u;
    u32x4 p0 = __builtin_bit_cast(u32x4, pack8(s[0], s[1])), p1 = __builtin_bit_cast(u32x4, pack8(s[2], s[3]));
    p0.x &= vm; p0.y &= vm; p0.z &= vm; p0.w &= vm; p1.x &= vm; p1.y &= vm; p1.z &= vm; p1.w &= vm;
    const bf16x8 b0 = __builtin_bit_cast(bf16x8, p0), b1 = __builtin_bit_cast(bf16x8, p1);
#pragma unroll
    for (int dt = 0; dt < 4; ++dt) { f.o[dt] = __builtin_amdgcn_mfma_f32_16x16x32_bf16(x.v[0][dt], b0, f.o[dt], 0, 0, 0); f.o[dt] = __builtin_amdgcn_mfma_f32_16x16x32_bf16(x.v[1][dt], b1, f.o[dt], 0, 0, 0); }
}
__device__ __forceinline__ float flash_finish(const Flash& f) { const float l = quad_allsum(f.l); return l > 0.f ? 1.f / l : 0.f; }

constexpr int NSA_WLDS = 10240;

__device__ __forceinline__ void nsa_q(const bf16_t* FE, const float* ROPE, int tcol, int head, int quad, bf16x8 (&qn)[2], bf16x8 (&qr)[2]) {
    const bf16_t* qrow = FE + (size_t)tcol * IN_PAD + C_Q + head * 64;
    qn[0] = *(const bf16x8*)(qrow + quad * 8); qn[1] = *(const bf16x8*)(qrow + 32 + quad * 8);
    qr[0] = qn[0]; qr[1] = qn[1];
    if (quad < 2) { const bf16x8 ot = *(const bf16x8*)(qrow + (quad ^ 1) * 8); const float* cs = ROPE + (size_t)tcol * 16; float v[8];
#pragma unroll
        for (int i = 0; i < 8; ++i) { const float x = bf2f((bf16_t)qn[0][i]), y = bf2f((bf16_t)ot[i]); v[i] = quad == 0 ? x * cs[i] - y * cs[8 + i] : x * cs[i] + y * cs[8 + i]; }
        u32x4 o; o.x = pk2(v[0], v[1]); o.y = pk2(v[2], v[3]); o.z = pk2(v[4], v[5]); o.w = pk2(v[6], v[7]); qr[0] = __builtin_bit_cast(bf16x8, o); }
}
__device__ __forceinline__ void nsa_tile_pre(unsigned char* ws, LAS unsigned char* wl, LAS unsigned* blkmask, LAS unsigned char* kvb, int tid, int ncb, int t0, int g, int lane, f32x4 (&oc)[4]) {
    const bf16_t* FE = (const bf16_t*)(ws + OFF_ACT);
    LAS float* impA = (LAS float*)wl; LAS float* impB = impA + 1024; LAS int* sel = (LAS int*)(impB + 1024);
    const int col = lane & 15, quad = lane >> 4, tok = col >> 2, hl = col & 3, head = g * 4 + hl, tcol = t0 + tok;
    bf16x8 qn[2];
    { const bf16_t* qrow = FE + (size_t)tcol * IN_PAD + C_Q + head * 64; qn[0] = *(const bf16x8*)(qrow + quad * 8); qn[1] = *(const bf16x8*)(qrow + 32 + quad * 8); }
    const int nmax_col = tcol >= 31 ? (tcol - 31) >> 4 : -1;
    const bf16_t* KC = (const bf16_t*)(ws + OFF_KCMP) + (size_t)g * 1024 * 64;
    const bf16_t* VCT = (const bf16_t*)(ws + OFF_VCMPT) + (size_t)g * 64 * 1024;
    float ml = -1e30f, ll = 0.f;
    __syncthreads();
    { const u32x4 k0 = *(const u32x4*)(KC + tid * 8); *(LAS u32x4*)(kvb + tid * 16) = k0; }
    __syncthreads();
    for (int jc = 0; jc < ncb; ++jc) {
        LAS unsigned char* cb = kvb + (jc & 1) * 16384; LAS unsigned char* nb = kvb + ((jc + 1) & 1) * 16384;
        u32x4 rk = {0u, 0u, 0u, 0u}; if (jc + 1 < ncb) rk = *(const u32x4*)(KC + (size_t)(jc + 1) * 4096 + tid * 8);
#pragma unroll
        for (int hf = 0; hf < 2; ++hf) { const int kb = jc * 64 + hf * 32; float sv[8]; float mx = -1e30f;
#pragma unroll
            for (int a = 0; a < 2; ++a) { f32x4 s = {0.f, 0.f, 0.f, 0.f};
#pragma unroll
                for (int ks = 0; ks < 2; ++ks) { const bf16x8 kf = *(const LAS bf16x8*)(cb + (((2 * hf + a) * 2 + ks) * 512 + col * 32 + quad * 8) * 2); s = __builtin_amdgcn_mfma_f32_16x16x32_bf16(kf, qn[ks], s, 0, 0, 0); }
#pragma unroll
                for (int r = 0; r < 4; ++r) { const int n = kb + 16 * a + quad * 4 + r; sv[a * 4 + r] = n <= nmax_col ? s[r] * QK_SCALE2 : -1e30f; mx = fmaxf(mx, sv[a * 4 + r]); } }
            const float mn = fmaxf(ml, mx); float ps = 0.f;
#pragma unroll
            for (int i = 0; i < 8; ++i) ps += sv[i] > -1e29f ? __builtin_amdgcn_exp2f(sv[i] - mn) : 0.f;
            ll = ll * __builtin_amdgcn_exp2f(ml - mn) + ps; ml = mn; }
        if (jc + 1 < ncb) *(LAS u32x4*)(nb + tid * 16) = rk;
        __syncthreads(); }
    const float M = quad_allmax(ml);
    const float L = quad_allsum(ll * __builtin_amdgcn_exp2f(ml - M));
    const float invL = L > 0.f ? 1.f / L : 0.f;
#pragma unroll
    for (int i = 0; i < 32; ++i) impA[i * 64 + lane] = 0.f;
    LDS_WAIT();
#pragma unroll
    for (int i = 0; i < 4; ++i) oc[i] = (f32x4){0.f, 0.f, 0.f, 0.f};
    { const u32x4 k0 = *(const u32x4*)(KC + tid * 8), v0 = *(const u32x4*)(VCT + tid * 8); *(LAS u32x4*)(kvb + tid * 16) = k0; *(LAS u32x4*)(kvb + 8192 + tid * 16) = v0; }
    __syncthreads();
    for (int jc = 0; jc < ncb; ++jc) {
        LAS unsigned char* cb = kvb + (jc & 1) * 16384; LAS unsigned char* nb = kvb + ((jc + 1) & 1) * 16384;
        u32x4 rk = {0u, 0u, 0u, 0u}, rv = rk;
        if (jc + 1 < ncb) { rk = *(const u32x4*)(KC + (size_t)(jc + 1) * 4096 + tid * 8); rv = *(const u32x4*)(VCT + (size_t)(jc + 1) * 4096 + tid * 8); }
#pragma unroll
        for (int hf = 0; hf < 2; ++hf) { const int kb = jc * 64 + hf * 32; f32x4 pr[2];
#pragma unroll
            for (int a = 0; a < 2; ++a) { f32x4 s = {0.f, 0.f, 0.f, 0.f};
#pragma unroll
                for (int ks = 0; ks < 2; ++ks) { const bf16x8 kf = *(const LAS bf16x8*)(cb + (((2 * hf + a) * 2 + ks) * 512 + col * 32 + quad * 8) * 2); s = __builtin_amdgcn_mfma_f32_16x16x32_bf16(kf, qn[ks], s, 0, 0, 0); }
#pragma unroll
                for (int r = 0; r < 4; ++r) { const int n = kb + 16 * a + quad * 4 + r; pr[a][r] = n <= nmax_col ? __builtin_amdgcn_exp2f(s[r] * QK_SCALE2 - M) * invL : 0.f; } }
            const bf16x8 pf = pack8(pr[0], pr[1]);
#pragma unroll
            for (int dt = 0; dt < 4; ++dt) { const bf16x8 vf = *(const LAS bf16x8*)(cb + 8192 + (hf * 2048 + dt * 512 + col * 32 + quad * 8) * 2);
                oc[dt] = __builtin_amdgcn_mfma_f32_16x16x32_bf16(vf, pf, oc[dt], 0, 0, 0); }
#pragma unroll
            for (int a = 0; a < 2; ++a) { float s4 = (pr[a][0] + pr[a][1]) + (pr[a][2] + pr[a][3]), p3 = pr[a][3];
                s4 += dppf<0xB1>(s4); s4 += dppf<0x4E>(s4); p3 += dppf<0xB1>(p3); p3 += dppf<0x4E>(p3);
                const int jj = ((kb + 16 * a) >> 2) + quad;
                if (hl == 0 && jj < 256) { impA[tok * 256 + jj] = s4; if (jj + 1 < 256) impB[tok * 256 + jj + 1] = p3; } } }
        if (jc + 1 < ncb) { *(LAS u32x4*)(nb + tid * 16) = rk; *(LAS u32x4*)(nb + 8192 + tid * 16) = rv; }
        __syncthreads(); }
    LDS_WAIT();
    for (int tk = 0; tk < 4; ++tk) { const int t = t0 + tk, cur = t >> 6; int cnt = 0;
        if (lane == 0) { sel[tk * 16 + 0] = 0; if (cur >= 1) sel[tk * 16 + 1] = cur; if (cur >= 2) sel[tk * 16 + 2] = cur - 1; }
        cnt = cur == 0 ? 1 : (cur == 1 ? 2 : 3);
        const int ncand = cur >= 2 ? cur - 2 : 0, nfree = 16 - cnt;
        if (ncand <= nfree) { if (lane < ncand) sel[tk * 16 + cnt + lane] = 1 + lane; cnt += ncand; }
        else { float v[4];
#pragma unroll
            for (int i = 0; i < 4; ++i) { const int j = lane * 4 + i; v[i] = (j >= 1 && j <= cur - 2) ? impA[tk * 256 + j] + impB[tk * 256 + j] : -1.f; }
            for (int rd = 0; rd < nfree; ++rd) { float bv = v[0]; int bi = 0;
#pragma unroll
                for (int i = 1; i < 4; ++i) if (v[i] > bv) { bv = v[i]; bi = i; }
                const float mx = wave_max(bv);
                const unsigned long long bal = __ballot(bv == mx); const int fl = __ffsll((long long)bal) - 1;
                const int bj = __shfl(lane * 4 + bi, fl);
                if (lane == fl) {
#pragma unroll
                    for (int i = 0; i < 4; ++i) if (i == bi) v[i] = -2.f; }
                if (lane == 0) sel[tk * 16 + cnt + rd] = bj; }
            cnt = 16; }
        LDS_WAIT();
        if (lane < cnt) { const int j = sel[tk * 16 + lane]; const int ti = (t0 & 63) + tk;
            __hip_atomic_fetch_or(blkmask + 2 * j + (ti >> 5), 1u << (ti & 31), __ATOMIC_RELAXED, __HIP_MEMORY_SCOPE_WORKGROUP); } }
    LDS_WAIT();
}
__device__ __forceinline__ void nsa_tile_add(unsigned char* ws, int t0, int g, int lane, const Flash& fb, int gi) {
    const bf16_t* FE = (const bf16_t*)(ws + OFF_ACT);
    const int col = lane & 15, quad = lane >> 4, tok = col >> 2, hl = col & 3, head = g * 4 + hl, tcol = t0 + tok;
    const float gb = sigmoidf_(bf2f(FE[(size_t)tcol * IN_PAD + C_GL + gi + head])) * flash_finish(fb);
    bf16_t* yo = (bf16_t*)(ws + OFF_XN) + (size_t)tcol * D_ + 1024 + head * 64 + quad * 4;
#pragma unroll
    for (int dt = 0; dt < 4; ++dt) { const u32x2 pc = *(const u32x2*)(yo + dt * 16);
        f32x4 o = gb * fb.o[dt];
        o[0] += __uint_as_float(pc.x << 16); o[1] += __uint_as_float(pc.x & 0xffff0000u); o[2] += __uint_as_float(pc.y << 16); o[3] += __uint_as_float(pc.y & 0xffff0000u);
        u32x2 v; v.x = pk2(o[0], o[1]); v.y = pk2(o[2], o[3]); *(u32x2*)(yo + dt * 16) = v; }
}
constexpr int NI_MASK = 0, NI_ID = 2048, NI_KV = 4096, NI_KVB = 4096 + 8 * NSA_WLDS;
__device__ __forceinline__ void nsa_item(unsigned char* ws, LAS unsigned char* lds, int qb, int g, int wave, int lane) {
    asm volatile("" : "+v"(lane));
    const bf16_t* FE = (const bf16_t*)(ws + OFF_ACT); const float* ROPE = (const float*)(ws + OFF_ROPE);
    LAS unsigned* blkmask = (LAS unsigned*)(lds + NI_MASK);
    LAS unsigned char* wl = lds + NI_KV + wave * NSA_WLDS;
    const int tid = wave * 64 + lane, col = lane & 15, quad = lane >> 4, tok = col >> 2, hl = col & 3, head = g * 4 + hl;
    const int tw = qb * 64 + wave * 8;
    blkmask[tid] = 0u;
    __syncthreads();
    for (int c = 0; c < 2; ++c) {
        f32x4 oc[4]; const int t0 = tw + 4 * c;
        nsa_tile_pre(ws, wl, blkmask, lds + NI_KVB, tid, ((4 * qb + 2) >> 6) + 1, t0, g, lane, oc);
        const float gc = sigmoidf_(bf2f(FE[(size_t)(t0 + tok) * IN_PAD + C_GL + head]));
        bf16_t* yo = (bf16_t*)(ws + OFF_XN) + (size_t)(t0 + tok) * D_ + 1024 + head * 64 + quad * 4;
#pragma unroll
        for (int dt = 0; dt < 4; ++dt) { u32x2 v; v.x = pk2(gc * oc[dt][0], gc * oc[dt][1]); v.y = pk2(gc * oc[dt][2], gc * oc[dt][3]); *(u32x2*)(yo + dt * 16) = v; } }
    __syncthreads();
    const bf16_t* KS = (const bf16_t*)(ws + OFF_KSR) + (size_t)g * S_ * 64;
    const bf16_t* VS = (const bf16_t*)(ws + OFF_VST) + (size_t)g * S_ * 64;
    LAS unsigned char* kvb = lds + NI_KVB;
    {
        bf16x8 qn[2], qr0[2], qr1[2];
        nsa_q(FE, ROPE, tw + tok, head, quad, qn, qr0);
        nsa_q(FE, ROPE, tw + 4 + tok, head, quad, qn, qr1);
        Flash f0, f1; flash_init(f0); flash_init(f1);
        __syncthreads();
        { const u32x4 k0 = *(const u32x4*)(KS + tid * 8), v0 = *(const u32x4*)(VS + tid * 8);
          *(LAS u32x4*)(kvb + tid * 16) = k0; *(LAS u32x4*)(kvb + 8192 + tid * 16) = v0; }
        u32x4 rk = {0u, 0u, 0u, 0u}, rv = rk;
        __syncthreads();
        for (int j = 0; j <= qb; ++j) {
            LAS unsigned char* cb = kvb + (j & 1) * 16384; LAS unsigned char* nb = kvb + ((j + 1) & 1) * 16384;
            if (j < qb) { rk = *(const u32x4*)(KS + (size_t)(j + 1) * 4096 + tid * 8); rv = *(const u32x4*)(VS + (size_t)(j + 1) * 4096 + tid * 8); }
            unsigned my8 = 0xFFu;
            if (j < qb) { const unsigned mw = __builtin_amdgcn_readfirstlane(blkmask[2 * j + (wave >> 2)]); my8 = (mw >> ((wave & 3) * 8)) & 0xFFu; }
            if (my8) {
                KV64 x;
#pragma unroll
                for (int a = 0; a < 4; ++a)
#pragma unroll
                    for (int ks = 0; ks < 2; ++ks) x.k[a][ks] = *(const LAS bf16x8*)(cb + ((a * 2 + ks) * 512 + col * 32 + quad * 8) * 2);
#pragma unroll
                for (int h = 0; h < 2; ++h)
#pragma unroll
                    for (int dt = 0; dt < 4; ++dt) x.v[h][dt] = *(const LAS bf16x8*)(cb + 8192 + (h * 2048 + dt * 512 + col * 32 + quad * 8) * 2);
                const unsigned b0 = my8 & 0xFu, b1 = my8 >> 4;
                if (j < qb) { if (b0) flash_block64v(f0, qr0, x, (b0 >> tok) & 1u); if (b1) flash_block64v(f1, qr1, x, (b1 >> tok) & 1u); }
                else { flash_block64(f0, qr0, x, qb * 64, 0, tw + tok, true, quad); flash_block64(f1, qr1, x, qb * 64, 0, tw + 4 + tok, true, quad); }
            }
            if (j < qb) { *(LAS u32x4*)(nb + tid * 16) = rk; *(LAS u32x4*)(nb + 8192 + tid * 16) = rv; }
            SCAN_BAR();
        }
        nsa_tile_add(ws, tw, g, lane, f0, 16); nsa_tile_add(ws, tw + 4, g, lane, f1, 16);
        flash_init(f0); flash_init(f1);
        { const bf16_t* KW = (const bf16_t*)(ws + OFF_KWR) + (size_t)g * S_ * 64;
          const bf16_t* VW = (const bf16_t*)(ws + OFF_VWT) + (size_t)g * S_ * 64;
          const int jw0 = qb >= 8 ? qb - 8 : 0;
          __syncthreads();
          rk = *(const u32x4*)(KW + (size_t)jw0 * 4096 + tid * 8); rv = *(const u32x4*)(VW + (size_t)jw0 * 4096 + tid * 8);
          *(LAS u32x4*)(kvb + (jw0 & 1) * 16384 + tid * 16) = rk; *(LAS u32x4*)(kvb + (jw0 & 1) * 16384 + 8192 + tid * 16) = rv;
          __syncthreads();
          for (int j = jw0; j <= qb; ++j) {
              LAS unsigned char* cb = kvb + (j & 1) * 16384; LAS unsigned char* nb = kvb + ((j + 1) & 1) * 16384;
              if (j < qb) { rk = *(const u32x4*)(KW + (size_t)(j + 1) * 4096 + tid * 8); rv = *(const u32x4*)(VW + (size_t)(j + 1) * 4096 + tid * 8); }
              KV64 x;
#pragma unroll
              for (int a = 0; a < 4; ++a)
#pragma unroll
                  for (int ks = 0; ks < 2; ++ks) x.k[a][ks] = *(const LAS bf16x8*)(cb + ((a * 2 + ks) * 512 + col * 32 + quad * 8) * 2);
#pragma unroll
              for (int h = 0; h < 2; ++h)
#pragma unroll
                  for (int dt = 0; dt < 4; ++dt) x.v[h][dt] = *(const LAS bf16x8*)(cb + 8192 + (h * 2048 + dt * 512 + col * 32 + quad * 8) * 2);
              if (j == qb || j + 8 == qb) { flash_block64(f0, qr0, x, j * 64, tw + tok - 511, tw + tok, true, quad); flash_block64(f1, qr1, x, j * 64, tw + 4 + tok - 511, tw + 4 + tok, true, quad); }
              else { flash_block64v(f0, qr0, x, true); flash_block64v(f1, qr1, x, true); }
              if (j < qb) { *(LAS u32x4*)(nb + tid * 16) = rk; *(LAS u32x4*)(nb + 8192 + tid * 16) = rv; }
              SCAN_BAR();
          } }
        nsa_tile_add(ws, tw, g, lane, f0, 32); nsa_tile_add(ws, tw + 4, g, lane, f1, 32);
    }
}

__device__ __forceinline__ void mem_attn_task(unsigned char* ws, int task, int lane) {
    const int h = task & 3, t0 = (task >> 2) * 16, col = lane & 15, quad = lane >> 4;
    const bf16_t* QM = (const bf16_t*)(ws + OFF_QM); const bf16_t* KM = (const bf16_t*)(ws + OFF_KM); const bf16_t* VMT = (const bf16_t*)(ws + OFF_VMT);
    bf16x8 q[4];
#pragma unroll
    for (int ks = 0; ks < 4; ++ks) q[ks] = *(const bf16x8*)(QM + (size_t)(t0 + col) * 512 + h * 128 + ks * 32 + quad * 8);
    float m = -1e30f, l = 0.f; f32x4 o[8];
#pragma unroll
    for (int i = 0; i < 8; ++i) o[i] = (f32x4){0.f, 0.f, 0.f, 0.f};
    const float sc = 0.08838834764831845f;
    for (int kb = 0; kb < 256; kb += 32) { f32x4 s[2]; float mx = -1e30f;
#pragma unroll
        for (int a = 0; a < 2; ++a) { s[a] = (f32x4){0.f, 0.f, 0.f, 0.f}; const bf16_t* kr = KM + (size_t)(kb + 16 * a + col) * 512 + h * 128 + quad * 8;
#pragma unroll
            for (int ks = 0; ks < 4; ++ks) { const bf16x8 kf = *(const bf16x8*)(kr + ks * 32); s[a] = __builtin_amdgcn_mfma_f32_16x16x32_bf16(kf, q[ks], s[a], 0, 0, 0); }
#pragma unroll
            for (int r = 0; r < 4; ++r) { s[a][r] *= sc; mx = fmaxf(mx, s[a][r]); } }
        mx = fmaxf(mx, __shfl_xor(mx, 16)); mx = fmaxf(mx, __shfl_xor(mx, 32));
        const float mn = fmaxf(m, mx), alpha = __expf(m - mn); m = mn; float ps = 0.f;
#pragma unroll
        for (int a = 0; a < 2; ++a)
#pragma unroll
            for (int r = 0; r < 4; ++r) { s[a][r] = __expf(s[a][r] - mn); ps += s[a][r]; }
        l = l * alpha + ps;
        const bf16x8 pf = pack8(s[0], s[1]);
#pragma unroll
        for (int dt = 0; dt < 8; ++dt) { const bf16_t* vr = VMT + (size_t)(h * 128 + dt * 16 + col) * 256 + kb + quad * 4; const bf16x8 vf = ld2x4(vr, vr + 16);
            o[dt] *= alpha; o[dt] = __builtin_amdgcn_mfma_f32_16x16x32_bf16(vf, pf, o[dt], 0, 0, 0); } }
    l += __shfl_xor(l, 16); l += __shfl_xor(l, 32); const float inv = 1.f / l;
    bf16_t* om = (bf16_t*)(ws + OFF_OM) + (size_t)(t0 + col) * 512 + h * 128 + quad * 4;
#pragma unroll
    for (int dt = 0; dt < 8; ++dt) { u32x2 v; v.x = pk2(o[dt][0] * inv, o[dt][1] * inv); v.y = pk2(o[dt][2] * inv, o[dt][3] * inv); *(u32x2*)(om + dt * 16) = v; }
}


__device__ __forceinline__ void gsync(unsigned* bar, unsigned target, int wave_s) {
    asm volatile("s_waitcnt vmcnt(0) lgkmcnt(0)" ::: "memory");
    __syncthreads();
    if (wave_s == 0) { int lane; asm volatile("v_mbcnt_lo_u32_b32 %0, -1, 0\n\tv_mbcnt_hi_u32_b32 %0, -1, %0" : "=v"(lane));
        if (lane == 0) { __builtin_amdgcn_fence(__ATOMIC_RELEASE, "agent");
            asm volatile("s_waitcnt vmcnt(0)" ::: "memory");
            __hip_atomic_fetch_add(bar, 1u, __ATOMIC_RELAXED, __HIP_MEMORY_SCOPE_AGENT);
            while (__hip_atomic_load(bar, __ATOMIC_RELAXED, __HIP_MEMORY_SCOPE_AGENT) < target) __builtin_amdgcn_s_sleep(20); } }
    __syncthreads();
    __builtin_amdgcn_fence(__ATOMIC_ACQUIRE, "agent");
    asm volatile("s_waitcnt vmcnt(0)" ::: "memory");
}
__device__ __forceinline__ void ffn_phases(unsigned* bar, unsigned& bar_t, LAS unsigned char* lds, unsigned char* ws, bf16_t* XN, bf16_t* ACT, bf16_t* Y, int G, int bid, const int wave_s) {
    { pg8::StaticOrder so; so.init(S_, 2 * FF_, G, bid);
      pg8::Gemm g{XN, (const bf16_t*)(ws + OFF_WGU), S_, 2 * FF_, D_};
      pg8::EpiSwiGLU e{ACT, FF_};
      pg8::gemm_phase(lds, g, so, e, wave_s); }
    bar_t += G; gsync(bar, bar_t, wave_s);
    { pg8::StaticOrder so; so.init(S_, D_, G, bid);
      pg8::Gemm g{ACT, (const bf16_t*)(ws + OFF_WD), S_, D_, FF_};
      pg8::EpiBf16 e{Y, D_};
      pg8::gemm_phase(lds, g, so, e, wave_s); }
    bar_t += G; gsync(bar, bar_t, wave_s);
}

__global__ void __launch_bounds__(512, 2) hymba_fwd(Params p) {
    extern __shared__ __attribute__((aligned(16))) unsigned char shm[];
    cg::grid_group grid = cg::this_grid();
    LAS unsigned char* lds = (LAS unsigned char*)shm;
    const int G = gridDim.x, bid = blockIdx.x;
    const int NGW = G * 8, NT = G * 512;
    unsigned char* ws = p.ws;
    bf16_t* XN = (bf16_t*)(ws + OFF_XN);
    bf16_t* ACT = (bf16_t*)(ws + OFF_ACT);
    bf16_t* Y = (bf16_t*)(ws + OFF_Y);
    unsigned* ctr = (unsigned*)(ws + OFF_CTR);
    unsigned* bar = ctr + 64; unsigned bar_t = 0;
    const int wave_s = __builtin_amdgcn_readfirstlane(threadIdx.x >> 6);
#define PHASE_IDX() int lane; asm volatile("v_mbcnt_lo_u32_b32 %0, -1, 0\n\tv_mbcnt_hi_u32_b32 %0, -1, %0" : "=v"(lane)); const int wave = wave_s; const int tid = wave * 64 + lane; (void)tid; const int gw = bid * 8 + wave, gtid = bid * 512 + tid; (void)gtid; (void)gw; (void)lane; LAS float* scr = (LAS float*)(lds + wave * 16384); (void)scr;

    {
        PHASE_IDX();
        conv_gateup(p.in[3], p.in[4], (bf16_t*)(ws + OFF_WGU), scr, lane, gw, NGW);
        conv_plain(p.in[5], FF_, D_, D_, (bf16_t*)(ws + OFF_WD), scr, lane, gw, NGW);
        conv_plain(p.in[8], D_, IN_COLS, IN_PAD, (bf16_t*)(ws + OFF_WIN), scr, lane, gw, NGW);
        conv_plain(p.in[26], D_, D_, D_, (bf16_t*)(ws + OFF_WOUT), scr, lane, gw, NGW);
        conv_plain(p.in[30], D_, 512, 512, (bf16_t*)(ws + OFF_WMQ), scr, lane, gw, NGW);
        conv_plain(p.in[32], 512, D_, D_, (bf16_t*)(ws + OFF_WMO), scr, lane, gw, NGW);
        conv_plain(p.in[31], D_, 1024, 1024, (bf16_t*)(ws + OFF_WMKV), scr, lane, gw, NGW);
        conv_plain(p.in[21], 2048, 128, 128, (bf16_t*)(ws + OFF_WC1K), scr, lane, gw, NGW);
        conv_plain(p.in[24], 2048, 128, 128, (bf16_t*)(ws + OFF_WC1V), scr, lane, gw, NGW);
        conv_plain(p.in[22], 128, 64, 64, (bf16_t*)(ws + OFF_WC2K), scr, lane, gw, NGW);
        conv_plain(p.in[25], 128, 64, 64, (bf16_t*)(ws + OFF_WC2V), scr, lane, gw, NGW);
        for (int row = gw; row < S_; row += NGW) rms_row_to_bf16(p.in[0] + (size_t)row * D_, p.in[2], XN + (size_t)row * D_, lane);
        for (int row = gw; row < MEM_; row += NGW) rms_row_to_bf16(p.in[1] + (size_t)row * D_, p.in[29], (bf16_t*)(ws + OFF_MEMN) + (size_t)row * D_, lane);
        { bf16_t* WL = (bf16_t*)(ws + OFF_WLORA);
          for (int i = gtid; i < LORA_N * LORA_K; i += NT) { const int n = i / LORA_K, k = i % LORA_K; float v = 0.f;
              if (n < 1024) { if (k < 64) v = p.in[11][k * 1024 + n]; }
              else if (n < 2048) { if (k >= 64 && k < 128) v = p.in[13][(k - 64) * 1024 + n - 1024]; }
              else { if (k >= 128 && k < 288) v = p.in[14][(k - 128) * 1024 + n - 2048]; }
              WL[i] = f2bf(v); } }
        { float* RP = (float*)(ws + OFF_ROPE);
          for (int i = gtid; i < S_ * 8; i += NT) { const int pos = i >> 3, f = i & 7;
              const float fr = f == 0 ? 1.000000000e+00f : f == 1 ? 1.939227432e-01f : f == 2 ? 3.760603070e-02f : f == 3 ? 7.292664610e-03f : f == 4 ? 1.414213562e-03f : f == 5 ? 2.742481884e-04f : f == 6 ? 5.318296098e-05f : 1.031338616e-05f;
              const float ang = (float)pos * fr;
              const double rev = (double)ang * 0.15915494309189535; const double fc = rev - rint(rev);
              const float rr = (float)(fc * 6.283185307179586);
              RP[pos * 16 + f] = cosf(rr); RP[pos * 16 + 8 + f] = sinf(rr); } }
    }
    grid.sync();
    ffn_phases(bar, bar_t, lds, ws, XN, ACT, Y, G, bid, wave_s);
    { PHASE_IDX(); norm_phase(p.in[0], Y, 0.5f, p.in[6], p.out, p.in[7], XN, lane, gw, NGW); }
    bar_t += G; gsync(bar, bar_t, wave_s);
    { pg8::StaticOrder so; so.init(S_, IN_PAD, G, bid);
      pg8::Gemm g{XN, (const bf16_t*)(ws + OFF_WIN), S_, IN_PAD, D_};
      pg8::EpiBf16 e{ACT, IN_PAD};
      pg8::gemm_phase(lds, g, so, e, wave_s); }
    bar_t += G; gsync(bar, bar_t, wave_s);
    {
        PHASE_IDX();
        const bf16_t* FE = ACT;
        if (wave < 2) { for (int task = bid * 2 + wave; task < 512; task += G * 2) compress_task(p, ws, task, lane); }
        else {
        const int gtid = (bid * 6 + wave - 2) * 64 + lane, NT = G * 384;
        { bf16_t* XL = (bf16_t*)(ws + OFF_XL);
          for (int i = gtid; i < S_ * LORA_K; i += NT) { const int t = i / LORA_K, c = i % LORA_K; float v = 0.f;
              if (c < 288) { const float s = shiftv(FE, t, C_WD + c, p.in[9][C_WD + c]); v = c < 64 ? tanhf_(s) : (c < 128 ? s : sigmoidf_(s)); }
              XL[i] = f2bf(v); } }
        { const float* RP = (const float*)(ws + OFF_ROPE);
          for (int i = gtid; i < S_ * 4 * 2; i += NT) { const int which = i & 1, g = (i >> 1) & 3, t = i >> 3;
              const bf16_t* srcp = FE + (size_t)t * IN_PAD + (which ? C_KW : C_KS) + g * 64;
              bf16_t* dstp = (bf16_t*)(ws + (which ? OFF_KWR : OFF_KSR)) + ((size_t)g * (S_ / 16) + (t >> 4)) * 1024 + (t & 15) * 32;
              const bf16x8 a = *(const bf16x8*)srcp, b = *(const bf16x8*)(srcp + 8); const float* cs = RP + (size_t)t * 16; float va[8], vb[8];
#pragma unroll
              for (int j = 0; j < 8; ++j) { const float x1 = bf2f((bf16_t)a[j]), x2 = bf2f((bf16_t)b[j]); va[j] = x1 * cs[j] - x2 * cs[8 + j]; vb[j] = x2 * cs[j] + x1 * cs[8 + j]; }
              u32x4 o; o.x = pk2(va[0], va[1]); o.y = pk2(va[2], va[3]); o.z = pk2(va[4], va[5]); o.w = pk2(va[6], va[7]); *(u32x4*)dstp = o;
              o.x = pk2(vb[0], vb[1]); o.y = pk2(vb[2], vb[3]); o.z = pk2(vb[4], vb[5]); o.w = pk2(vb[6], vb[7]); *(u32x4*)(dstp + 8) = o;
#pragma unroll
              for (int j = 2; j < 8; ++j) *(u32x4*)(dstp + (j >> 2) * 512 + (j & 3) * 8) = *(const u32x4*)(srcp + j * 8); } }
        { for (int i = gtid; i < 2 * 256 * (S_ / 8); i += NT) { const int gd = i & 255, which = (i >> 8) & 1, tc = i >> 9;
              const bf16_t* srcp = FE + (size_t)tc * 8 * IN_PAD + (which ? C_VW : C_VS) + gd;
              bf16_t v[8];
#pragma unroll
              for (int j = 0; j < 8; ++j) v[j] = srcp[(size_t)j * IN_PAD];
              u32x4 o; o.x = v[0] | ((unsigned)v[1] << 16); o.y = v[2] | ((unsigned)v[3] << 16); o.z = v[4] | ((unsigned)v[5] << 16); o.w = v[6] | ((unsigned)v[7] << 16);
              bf16_t* dv = (bf16_t*)(ws + (which ? OFF_VWT : OFF_VST)) + (((size_t)(gd >> 6) * (S_ / 32) + (tc >> 2)) * 4 + ((gd & 63) >> 4)) * 512 + (gd & 15) * 32 + (tc & 1) * 16 + ((tc & 3) >> 1) * 4;
              u32x2 lo2; lo2.x = o.x; lo2.y = o.y; u32x2 hi2; hi2.x = o.z; hi2.y = o.w; *(u32x2*)dv = lo2; *(u32x2*)(dv + 8) = hi2; } }
        }
    }
    bar_t += G; gsync(bar, bar_t, wave_s);
    { pg8::StaticOrder so; so.init(S_, LORA_N, G, bid);
      pg8::Gemm g{(const bf16_t*)(ws + OFF_XL), (const bf16_t*)(ws + OFF_WLORA), S_, LORA_N, LORA_K};
      EpiLora e{(bf16_t*)(ws + OFF_LORA), p.in[10], p.in[12]};
      pg8::gemm_phase(lds, g, so, e, wave_s); }
    bar_t += G; gsync(bar, bar_t, wave_s);
    { PHASE_IDX();
    if (bid < 64) { rwkv_scan_block(p, ws, lds, bid, tid); }
    { {
        const int g0 = (int)(__builtin_amdgcn_s_getreg((3 << 11) | 20) & 3u);
        LAS unsigned* idw = (LAS unsigned*)(lds + NI_ID);
        for (int gi = 0; gi < 4; ++gi) { const int g = (g0 + gi) & 3;
          for (;;) { __syncthreads();
            if (tid == 0) *idw = atomicAdd(ctr + g, 1u);
            __syncthreads();
            const unsigned id = __builtin_amdgcn_readfirstlane(*idw);
            if (id >= (unsigned)(S_ / 64)) break;
            nsa_item(ws, lds, (S_ / 64 - 1) - (int)id, g, wave, lane); } } }
    } }
    bar_t += G; gsync(bar, bar_t, wave_s);
    {
        PHASE_IDX();
        const bf16_t* FE = ACT; const bf16_t* LO = (const bf16_t*)(ws + OFF_LORA); const bf16_t* YR = (const bf16_t*)(ws + OFF_YRAW);
        for (int task = gw; task < S_ * 4; task += NGW) { const int t4 = (task >> 4) * 4, h = task & 15, c = h * 64 + lane;
            const float mu_r = p.in[9][C_R + c], mu_k = p.in[9][C_K + c], mu_v = p.in[9][C_V + c], lnw = p.in[18][c], lnb = p.in[19][c], kaw = p.in[16][c], rkw = p.in[17][c];
            float fr[5], fk[5], fv[5], yy[4], aa[4], gg[4];
#pragma unroll
            for (int i = 0; i < 5; ++i) { const int t = t4 - 1 + i;
                if (t >= 0) { fr[i] = bf2f(FE[(size_t)t * IN_PAD + C_R + c]); fk[i] = bf2f(FE[(size_t)t * IN_PAD + C_K + c]); fv[i] = bf2f(FE[(size_t)t * IN_PAD + C_V + c]); }
                else { fr[i] = 0.f; fk[i] = 0.f; fv[i] = 0.f; } }
#pragma unroll
            for (int i = 0; i < 4; ++i) { const int t = t4 + i; yy[i] = bf2f(YR[(size_t)t * 1024 + c]); aa[i] = bf2f(LO[(size_t)t * LORA_N + 1024 + c]); gg[i] = bf2f(LO[(size_t)t * LORA_N + 2048 + c]); }
#pragma unroll
            for (int i = 0; i < 4; ++i) {
                const float y = yy[i]; const float mean = wave_sum(y) * (1.f / 64.f); const float d = y - mean; const float var = wave_sum(d * d) * (1.f / 64.f);
                const float yn = d * rsqrtf(var + 64e-5f) * lnw + lnb;
                const float r = fr[i + 1] + mu_r * (fr[i] - fr[i + 1]), k = fk[i + 1] + mu_k * (fk[i] - fk[i + 1]), v = fv[i + 1] + mu_v * (fv[i] - fv[i + 1]);
                const float kp = k * (1.f + (aa[i] - 1.f) * kaw);
                const float bonus = wave_sum(r * kp * rkw) * v;
                XN[(size_t)(t4 + i) * D_ + c] = f2bf((yn + bonus) * gg[i]); } }
    }
    bar_t += G; gsync(bar, bar_t, wave_s);
    { pg8::StaticOrder so; so.init(S_, D_, G, bid);
      pg8::Gemm g{XN, (const bf16_t*)(ws + OFF_WOUT), S_, D_, D_};
      pg8::EpiBf16 e{Y, D_};
      pg8::gemm_phase(lds, g, so, e, wave_s); }
    bar_t += G; gsync(bar, bar_t, wave_s);
    { PHASE_IDX();
    norm_phase(p.out, Y, 1.0f, p.in[27], p.out, p.in[28], XN, lane, gw, NGW);
    conv_gateup(p.in[35], p.in[36], (bf16_t*)(ws + OFF_WGU), scr, lane, gw, NGW);
    conv_plain(p.in[37], FF_, D_, D_, (bf16_t*)(ws + OFF_WD), scr, lane, gw, NGW); }
    bar_t += G; gsync(bar, bar_t, wave_s);
    { pg8::StaticOrder so; so.init(S_, 512, G, bid);
      pg8::Gemm g{XN, (const bf16_t*)(ws + OFF_WMQ), S_, 512, D_};
      pg8::EpiBf16 e{(bf16_t*)(ws + OFF_QM), 512};
      pg8::gemm_phase(lds, g, so, e, wave_s); }
    if (bid >= 128) {
        PHASE_IDX();
        const int kw = (bid - 128) * 8 + wave, KNW = (G - 128) * 8;
        for (int task = kw; task < 1024; task += KNW) { const int mt = task >> 6, nt = task & 63; const int col = lane & 15, quad = lane >> 4;
            const f32x4 c = wave_tile_gemm((const bf16_t*)(ws + OFF_MEMN) + (size_t)mt * 16 * D_, D_, (const bf16_t*)(ws + OFF_WMKV) + (size_t)nt * 16 * D_, D_, D_, lane);
            const int cc = nt * 16 + col, key = mt * 16 + quad * 4;
            if (cc < 512) { bf16_t* K = (bf16_t*)(ws + OFF_KM);
#pragma unroll
                for (int r = 0; r < 4; ++r) K[(size_t)(key + r) * 512 + cc] = f2bf(c[r]); }
            else { bf16_t* V = (bf16_t*)(ws + OFF_VMT) + (size_t)(cc - 512) * 256 + key; u32x2 v; v.x = pk2(c[0], c[1]); v.y = pk2(c[2], c[3]); *(u32x2*)V = v; } }
    }
    bar_t += G; gsync(bar, bar_t, wave_s);
    { PHASE_IDX(); for (int task = gw; task < (S_ / 16) * 4; task += NGW) mem_attn_task(ws, task, lane); }
    bar_t += G; gsync(bar, bar_t, wave_s);
    { pg8::StaticOrder so; so.init(S_, D_, G, bid);
      pg8::Gemm g{(const bf16_t*)(ws + OFF_OM), (const bf16_t*)(ws + OFF_WMO), S_, D_, 512};
      pg8::EpiBf16 e{Y, D_};
      pg8::gemm_phase(lds, g, so, e, wave_s); }
    bar_t += G; gsync(bar, bar_t, wave_s);
    { PHASE_IDX(); norm_phase(p.out, Y, 1.0f, p.in[33], p.out, p.in[34], XN, lane, gw, NGW); }
    bar_t += G; gsync(bar, bar_t, wave_s);
    ffn_phases(bar, bar_t, lds, ws, XN, ACT, Y, G, bid, wave_s);
    { PHASE_IDX(); norm_phase(p.out, Y, 0.5f, p.in[38], p.out, nullptr, XN, lane, gw, NGW); }
}

extern "C" void kernel_launch(void* const* d_in, const int* in_sizes, int n_in, void* d_out, int out_size, void* d_ws, size_t ws_size, hipStream_t stream) {
    constexpr size_t kDynLds = 131072;
    static int grid_blocks = 0;
    if (!grid_blocks) {
        if (n_in != 39 || out_size != S_ * D_ || ws_size < WS_END) { fprintf(stderr, "kernel_launch: unexpected shapes n_in %d out %d ws %zu (need %zu)\n", n_in, out_size, ws_size, (size_t)WS_END); grid_blocks = -1; return; }
        int dev = 0, cus = 0, per_cu = 0;
        hipGetDevice(&dev);
        hipDeviceGetAttribute(&cus, hipDeviceAttributeMultiprocessorCount, dev);
        hipFuncSetAttribute((const void*)hymba_fwd, hipFuncAttributeMaxDynamicSharedMemorySize, (int)kDynLds);
        hipOccupancyMaxActiveBlocksPerMultiprocessor(&per_cu, (const void*)hymba_fwd, 512, kDynLds);
        if (per_cu < 1) per_cu = 1;
        grid_blocks = cus * per_cu;
        if (grid_blocks > 256) grid_blocks = 256;
    }
    if (grid_blocks < 0) return;
    Params p{};
    for (int i = 0; i < 39; ++i) p.in[i] = (const float*)d_in[i];
    p.out = (float*)d_out; p.ws = (unsigned char*)d_ws;
    if (hipMemsetAsync((unsigned char*)d_ws + OFF_CTR, 0, 1024, stream) != hipSuccess) { fprintf(stderr, "memset failed\n"); return; }
    void* args[] = {&p};
    hipError_t e = hipLaunchCooperativeKernel((const void*)hymba_fwd, dim3(grid_blocks), dim3(512), args, kDynLds, stream);
    if (e != hipSuccess) fprintf(stderr, "cooperative launch failed: %s (grid %d)\n", hipGetErrorString(e), grid_blocks);
}
```

```cpp
#include <hip/hip_runtime.h>
#include <hip/hip_cooperative_groups.h>
#include <cstdio>
namespace cg = cooperative_groups;


#define LAS __attribute__((address_space(3)))
typedef unsigned short bf16_t;
typedef short bf16x8 __attribute__((ext_vector_type(8)));
typedef float f32x4 __attribute__((ext_vector_type(4)));
typedef float f32x2 __attribute__((ext_vector_type(2)));
typedef unsigned u32x4 __attribute__((ext_vector_type(4)));
typedef unsigned u32x2 __attribute__((ext_vector_type(2)));

constexpr int S_ = 16384, D_ = 2048, FF_ = 5504, MEM_ = 256;
constexpr int RW_COLS = 3360, NSA_COLS = 2608, IN_COLS = 5968, IN_PAD = 6144;
constexpr int LORA_K = 384, LORA_N = 3072;
constexpr float EPS_ = 1e-6f;

constexpr size_t SZ_WGU = (size_t)2 * FF_ * D_ * 2, SZ_WD = (size_t)D_ * FF_ * 2;
constexpr size_t OFF_WGU = 0;
constexpr size_t OFF_WD = OFF_WGU + SZ_WGU;
constexpr size_t OFF_WIN = OFF_WD + SZ_WD;
constexpr size_t OFF_WOUT = OFF_WIN + (size_t)IN_PAD * D_ * 2;
constexpr size_t OFF_WMQ = OFF_WOUT + (size_t)D_ * D_ * 2;
constexpr size_t OFF_WMO = OFF_WMQ + (size_t)512 * D_ * 2;
constexpr size_t OFF_WMKV = OFF_WMO + (size_t)D_ * 512 * 2;
constexpr size_t OFF_WLORA = OFF_WMKV + (size_t)1024 * D_ * 2;
constexpr size_t OFF_WC1K = OFF_WLORA + (size_t)LORA_N * LORA_K * 2;
constexpr size_t OFF_WC1V = OFF_WC1K + (size_t)128 * 2048 * 2;
constexpr size_t OFF_WC2K = OFF_WC1V + (size_t)128 * 2048 * 2;
constexpr size_t OFF_WC2V = OFF_WC2K + (size_t)64 * 128 * 2;
constexpr size_t OFF_MEMN = OFF_WC2V + (size_t)64 * 128 * 2;
constexpr size_t OFF_KM = OFF_MEMN + (size_t)MEM_ * D_ * 2;
constexpr size_t OFF_VMT = OFF_KM + (size_t)MEM_ * 512 * 2;
constexpr size_t OFF_KCMP = OFF_VMT + (size_t)MEM_ * 512 * 2;
constexpr size_t OFF_VCMPT = OFF_KCMP + (size_t)4 * 1024 * 64 * 2;
constexpr size_t OFF_ROPE = OFF_VCMPT + (size_t)4 * 1024 * 64 * 2;
constexpr size_t OFF_CTR = OFF_ROPE + (size_t)S_ * 16 * 4;
constexpr size_t OFF_XN = ((OFF_CTR + 4096 + 1048575) / 1048576) * 1048576;
constexpr size_t OFF_ACT = OFF_XN + (size_t)S_ * D_ * 2;
constexpr size_t OFF_Y = OFF_ACT + (size_t)S_ * IN_PAD * 2;
constexpr size_t WS_END = OFF_Y + (size_t)S_ * D_ * 4;
constexpr size_t OFF_KSR = 0;
constexpr size_t OFF_KWR = OFF_KSR + (size_t)S_ * 256 * 2;
constexpr size_t OFF_VST = OFF_KWR + (size_t)S_ * 256 * 2;
constexpr size_t OFF_VWT = OFF_VST + (size_t)S_ * 256 * 2;
constexpr size_t OFF_XL = OFF_VWT + (size_t)S_ * 256 * 2;
constexpr size_t OFF_KN2 = OFF_XL + (size_t)S_ * LORA_K * 2;
constexpr size_t OFF_MIXEND = OFF_KN2 + (size_t)S_ * 16 * 4;
static_assert(OFF_MIXEND <= OFF_WIN, "mix temporaries overflow the FFN weight region");
constexpr size_t OFF_LORA = OFF_Y;
constexpr size_t OFF_YRAW = OFF_Y + (size_t)S_ * LORA_N * 2;
constexpr size_t OFF_QM = OFF_ACT;
constexpr size_t OFF_OM = OFF_ACT + (size_t)S_ * 512 * 2;

struct Params {
    const float* in[39];
    float* out;
    unsigned char* ws;
};

__device__ __forceinline__ float bf2f(bf16_t b) { return __uint_as_float(((unsigned)b) << 16); }
__device__ __forceinline__ unsigned pk2(float lo, float hi) { unsigned r; asm("v_cvt_pk_bf16_f32 %0, %1, %2" : "=v"(r) : "v"(lo), "v"(hi)); return r; }
__device__ __forceinline__ bf16_t f2bf(float f) { return (bf16_t)(pk2(f, 0.f) & 0xffffu); }
template <int CTRL> __device__ __forceinline__ float dppf(float x) { return __int_as_float(__builtin_amdgcn_update_dpp(0, __float_as_int(x), CTRL, 0xf, 0xf, false)); }
__device__ __forceinline__ float rowsum16(float x) { x += dppf<0x128>(x); x += dppf<0x124>(x); x += dppf<0x122>(x); x += dppf<0x121>(x); return x; }
__device__ __forceinline__ float rowmax16(float x) { x = fmaxf(x, dppf<0x128>(x)); x = fmaxf(x, dppf<0x124>(x)); x = fmaxf(x, dppf<0x122>(x)); x = fmaxf(x, dppf<0x121>(x)); return x; }
__device__ __forceinline__ float quad_allmax(float x) {
    auto r = __builtin_amdgcn_permlane32_swap(__float_as_uint(x), __float_as_uint(x), false, false); x = fmaxf(__uint_as_float(r[0]), __uint_as_float(r[1]));
    auto q = __builtin_amdgcn_permlane16_swap(__float_as_uint(x), __float_as_uint(x), false, false); return fmaxf(__uint_as_float(q[0]), __uint_as_float(q[1]));
}
__device__ __forceinline__ float quad_allsum(float x) {
    auto r = __builtin_amdgcn_permlane32_swap(__float_as_uint(x), __float_as_uint(x), false, false); x = __uint_as_float(r[0]) + __uint_as_float(r[1]);
    auto q = __builtin_amdgcn_permlane16_swap(__float_as_uint(x), __float_as_uint(x), false, false); return __uint_as_float(q[0]) + __uint_as_float(q[1]);
}
__device__ __forceinline__ float wave_sum(float v) { return quad_allsum(rowsum16(v)); }
__device__ __forceinline__ float wave_max(float v) { return quad_allmax(rowmax16(v)); }
template <int CTRL> __device__ __forceinline__ unsigned dppu(unsigned x) { return (unsigned)__builtin_amdgcn_update_dpp(0, (int)x, CTRL, 0xf, 0xf, false); }
__device__ __forceinline__ unsigned umax_(unsigned a, unsigned b) { return a > b ? a : b; }
__device__ __forceinline__ unsigned wave_max_u(unsigned x) {
    x = umax_(x, dppu<0x128>(x)); x = umax_(x, dppu<0x124>(x)); x = umax_(x, dppu<0x122>(x)); x = umax_(x, dppu<0x121>(x));
    auto r = __builtin_amdgcn_permlane32_swap(x, x, false, false); x = umax_(r[0], r[1]);
    auto q = __builtin_amdgcn_permlane16_swap(x, x, false, false); return umax_(q[0], q[1]);
}
__device__ __forceinline__ float sigmoidf_(float x) { return __builtin_amdgcn_rcpf(1.f + __expf(-x)); }
#define LDS_WAIT() asm volatile("s_waitcnt lgkmcnt(0)" ::: "memory")

namespace pg8 {
constexpr int BM = 256, BK = 64, HALF = 128, HTB = HALF * BK * 2, STAGE_BYTES = 8 * HTB, NXCD = 8, WGM = 4;
__host__ __device__ __forceinline__ int lds_byte(int r, int c) { const int st = (r >> 4) * 2 + (c >> 5), rr = r & 15, cc = c & 31, ob = rr * 64 + cc * 2; return st * 1024 + (ob ^ (((ob >> 9) & 1) << 5)); }
__host__ __device__ __forceinline__ void stage_rc(int b, int& R, int& C) { const int st = b / 1024, sb = b % 1024, swz = sb ^ (((sb >> 9) & 1) << 5); R = (st >> 1) * 16 + swz / 64; C = (st & 1) * 32 + (swz % 64) / 2; }
__host__ __device__ __forceinline__ int perm32(int rho) { const int n = rho >> 4, i = rho & 15; return 8 * (i >> 2) + 4 * n + (i & 3); }
struct Unit { int pm, pn; };
struct Gemm { const bf16_t* A; const bf16_t* Bt; int M, N, K; };
struct StaticOrder {
    int nM, nN, nwg, G, c;
    __device__ void init(int M, int N, int G_, int c_) { nM = M / BM; nN = N / BM; nwg = nM * nN; G = G_; c = c_; }
    __device__ bool next(int i, Unit& u) const {
        const long L = (long)i * G + c; if (L >= nwg) return false;
        int wgid = (int)L; { const int q = nwg / NXCD, r = nwg % NXCD, xcd = wgid % NXCD, off = wgid / NXCD; wgid = (xcd < r ? xcd * (q + 1) : r * (q + 1) + (xcd - r) * q) + off; }
        const int nig = WGM * nN, gid = wgid / nig, fm = gid * WGM, gsz = (nM - fm) < WGM ? (nM - fm) : WGM;
        u.pm = fm + ((wgid % nig) % gsz); u.pn = (wgid % nig) / gsz; return true;
    }
};

template <class Epi>
__device__ __forceinline__ void gemm_phase(LAS unsigned char* lds, const Gemm g, const StaticOrder& S, const Epi& E, const int wave_s) {
    int lane; asm volatile("v_mbcnt_lo_u32_b32 %0, -1, 0\n\tv_mbcnt_hi_u32_b32 %0, -1, %0" : "=v"(lane));
    const int wid = wave_s; const int tid = wid * 64 + lane; const int wr = wid >> 2, wc = wid & 3, fr = lane & 15, fq = lane >> 4;
    const int K = g.K, nt = K / BK;
    unsigned voffA[2], voffB[2];
#pragma unroll
    for (int i = 0; i < 2; ++i) { int R, C; stage_rc(tid * 16 + i * 8192, R, C); const int Rb = Epi::PERM ? ((R & ~31) + perm32(R & 31)) : R;
        voffA[i] = (unsigned)(R * K + C) * 2u; voffB[i] = (unsigned)(Rb * K + C) * 2u; }
    const size_t kstep = (size_t)(BK * 2);
    const size_t hstep = (size_t)HALF * K * 2;
    const size_t tstep = 2 * hstep;
    const unsigned ldsw = (unsigned)wid * 1024u;
    const int aoff = lds_byte(wr * 64 + fr, fq * 8), boff = lds_byte(wc * 32 + fr, fq * 8);
#define PG8_SA(b, h) (((b) * 2 + (h)) * HTB)
#define PG8_SB(b, h) ((4 + (b) * 2 + (h)) * HTB)
#define PG8_STAGE(bufoff, gbase, voff) do { _Pragma("unroll") for (int _i = 0; _i < 2; ++_i) \
        __builtin_amdgcn_global_load_lds((const unsigned*)((const char*)(gbase) + (voff)[_i]), (LAS unsigned*)(lds + (bufoff) + ldsw + _i * 8192), 16, 0, 0); } while (0)
#define PG8_LDA(dst, b, h) do { _Pragma("unroll") for (int m = 0; m < 4; ++m) _Pragma("unroll") for (int k = 0; k < 2; ++k) dst[m][k] = *(const LAS bf16x8*)(lds + PG8_SA(b, h) + aoff + m * 2048 + k * 1024); } while (0)
#define PG8_LDB(dst, b, h) do { _Pragma("unroll") for (int n = 0; n < 2; ++n) _Pragma("unroll") for (int k = 0; k < 2; ++k) dst[n][k] = *(const LAS bf16x8*)(lds + PG8_SB(b, h) + boff + n * 2048 + k * 1024); } while (0)
#define PG8_MMA(ai, bj, At, Bt) do { __builtin_amdgcn_s_setprio(1); _Pragma("unroll") for (int m = 0; m < 4; ++m) _Pragma("unroll") for (int n = 0; n < 2; ++n) _Pragma("unroll") for (int k = 0; k < 2; ++k) \
        acc[ai][bj][m][n] = __builtin_amdgcn_mfma_f32_16x16x32_bf16(Bt[n][k], At[m][k], acc[ai][bj][m][n], 0, 0, 0); __builtin_amdgcn_s_setprio(0); } while (0)
#define PG8_WAIT_V(n) asm volatile("s_waitcnt vmcnt(" #n ")" ::: "memory")
#define PG8_WAIT_L(n) asm volatile("s_waitcnt lgkmcnt(" #n ")" ::: "memory")
#define PG8_BAR __builtin_amdgcn_s_barrier()
#define PG8_SCHED __builtin_amdgcn_sched_barrier(0)
    Unit cur, nxt; int ui = 0;
    if (!S.next(0, cur)) return;
    f32x4 acc[2][2][4][2];
#pragma unroll
    for (int a = 0; a < 2; ++a)
#pragma unroll
        for (int b = 0; b < 2; ++b)
#pragma unroll
            for (int m = 0; m < 4; ++m)
#pragma unroll
                for (int n = 0; n < 2; ++n) acc[a][b][m][n] = (f32x4){0.f, 0.f, 0.f, 0.f};
    bf16x8 At[4][2], B0[2][2], B1[2][2];
    const char* cA = (const char*)g.A + (size_t)cur.pm * tstep; const char* cB = (const char*)g.Bt + (size_t)cur.pn * tstep;
    PG8_STAGE(PG8_SB(0, 0), cB, voffB); PG8_STAGE(PG8_SA(0, 0), cA, voffA); PG8_STAGE(PG8_SB(0, 1), cB + hstep, voffB); PG8_STAGE(PG8_SA(0, 1), cA + hstep, voffA);
    if (wr == 1) PG8_BAR;
    PG8_WAIT_V(4); PG8_BAR;
    PG8_STAGE(PG8_SB(1, 0), cB + kstep, voffB); PG8_STAGE(PG8_SA(1, 0), cA + kstep, voffA); PG8_STAGE(PG8_SB(1, 1), cB + hstep + kstep, voffB);
    PG8_WAIT_V(6); PG8_BAR;
    for (;;) {
        const bool has_next = S.next(ui + 1, nxt);
        const char* nA = has_next ? (const char*)g.A + (size_t)nxt.pm * tstep : cA; const char* nB = has_next ? (const char*)g.Bt + (size_t)nxt.pn * tstep : cB;
        for (int t = 0; t < nt; t += 2) {
            const bool last = (t == nt - 2);
            const char* a1 = cA + (size_t)(t + 1) * kstep;
            const char* a2 = last ? nA : cA + (size_t)(t + 2) * kstep; const char* b2 = last ? nB : cB + (size_t)(t + 2) * kstep;
            const char* a3 = a2 + kstep; const char* b3 = b2 + kstep;
            PG8_LDB(B0, 0, 0); PG8_SCHED; PG8_LDA(At, 0, 0); PG8_STAGE(PG8_SA(1, 1), a1 + hstep, voffA);
            PG8_WAIT_L(8); PG8_BAR; PG8_WAIT_L(0); PG8_MMA(0, 0, At, B0); PG8_BAR; PG8_SCHED;
            PG8_LDB(B1, 0, 1); PG8_STAGE(PG8_SB(0, 0), b2, voffB);
            PG8_BAR; PG8_WAIT_L(0); PG8_MMA(0, 1, At, B1); PG8_BAR;
            PG8_LDA(At, 0, 1); PG8_STAGE(PG8_SA(0, 0), a2, voffA);
            PG8_BAR; PG8_WAIT_L(0); PG8_MMA(1, 0, At, B0); PG8_BAR; PG8_SCHED;
            PG8_STAGE(PG8_SB(0, 1), b2 + hstep, voffB);
            PG8_WAIT_V(6); PG8_BAR; PG8_MMA(1, 1, At, B1); PG8_BAR;
            PG8_LDB(B0, 1, 0); PG8_SCHED; PG8_LDA(At, 1, 0); PG8_STAGE(PG8_SA(0, 1), a2 + hstep, voffA);
            PG8_WAIT_L(8); PG8_BAR; PG8_WAIT_L(0); PG8_MMA(0, 0, At, B0); PG8_BAR; PG8_SCHED;
            PG8_LDB(B1, 1, 1); PG8_STAGE(PG8_SB(1, 0), b3, voffB);
            PG8_BAR; PG8_WAIT_L(0); PG8_MMA(0, 1, At, B1); PG8_BAR;
            PG8_LDA(At, 1, 1); PG8_STAGE(PG8_SA(1, 0), a3, voffA);
            PG8_BAR; PG8_WAIT_L(0); PG8_MMA(1, 0, At, B0); PG8_BAR; PG8_SCHED;
            PG8_STAGE(PG8_SB(1, 1), b3 + hstep, voffB);
            PG8_WAIT_V(6); PG8_BAR; PG8_MMA(1, 1, At, B1); PG8_BAR;
        }
        E(acc, cur, wr, wc, fr, fq);
        if (!has_next) break;
#pragma unroll
        for (int a = 0; a < 2; ++a)
#pragma unroll
            for (int b = 0; b < 2; ++b)
#pragma unroll
                for (int m = 0; m < 4; ++m)
#pragma unroll
                    for (int n = 0; n < 2; ++n) acc[a][b][m][n] = (f32x4){0.f, 0.f, 0.f, 0.f};
        cur = nxt; cA = nA; cB = nB; ++ui;
    }
    PG8_WAIT_V(0);
    if (wr == 0) PG8_BAR;
    PG8_BAR;
#undef PG8_SA
#undef PG8_SB
#undef PG8_STAGE
#undef PG8_LDA
#undef PG8_LDB
#undef PG8_MMA
#undef PG8_WAIT_V
#undef PG8_WAIT_L
#undef PG8_BAR
#undef PG8_SCHED
}

struct EpiF32 {
    static constexpr bool PERM = false;
    float* C; int ldc;
    __device__ __forceinline__ void operator()(const f32x4 (&acc)[2][2][4][2], const Unit& u, int wr, int wc, int fr, int fq) const {
        const int row0 = u.pm * BM + wr * 64 + fr, col0 = u.pn * BM + wc * 32 + 4 * fq;
#pragma unroll
        for (int ai = 0; ai < 2; ++ai)
#pragma unroll
            for (int m = 0; m < 4; ++m) { float* rowp = C + (size_t)(row0 + ai * HALF + m * 16) * ldc + col0;
#pragma unroll
                for (int bj = 0; bj < 2; ++bj)
#pragma unroll
                    for (int n = 0; n < 2; ++n) *(f32x4*)(rowp + bj * HALF + n * 16) = acc[ai][bj][m][n]; }
    }
};
struct EpiBf16 {
    static constexpr bool PERM = true;
    bf16_t* O; int ldc;
    __device__ __forceinline__ void operator()(const f32x4 (&acc)[2][2][4][2], const Unit& u, int wr, int wc, int fr, int fq) const {
        const int row0 = u.pm * BM + wr * 64 + fr, col0 = u.pn * BM + wc * 32 + 8 * fq;
#pragma unroll
        for (int ai = 0; ai < 2; ++ai)
#pragma unroll
            for (int m = 0; m < 4; ++m) { bf16_t* rowp = O + (size_t)(row0 + ai * HALF + m * 16) * ldc + col0;
#pragma unroll
                for (int bj = 0; bj < 2; ++bj) { const f32x4 v0 = acc[ai][bj][m][0], v1 = acc[ai][bj][m][1];
                    u32x4 o; o.x = pk2(v0[0], v0[1]); o.y = pk2(v0[2], v0[3]); o.z = pk2(v1[0], v1[1]); o.w = pk2(v1[2], v1[3]);
                    *(u32x4*)(rowp + bj * HALF) = o; } }
    }
};
struct EpiSwiGLU {
    static constexpr bool PERM = true;
    bf16_t* O; int ldc;
    __device__ __forceinline__ void operator()(const f32x4 (&acc)[2][2][4][2], const Unit& u, int wr, int wc, int fr, int fq) const {
        const int row0 = u.pm * BM + wr * 64 + fr, col0 = u.pn * HALF + wc * 32 + 8 * fq;
#pragma unroll
        for (int ai = 0; ai < 2; ++ai)
#pragma unroll
            for (int m = 0; m < 4; ++m) { bf16_t* rowp = O + (size_t)(row0 + ai * HALF + m * 16) * ldc + col0;
                float v[8];
#pragma unroll
                for (int n = 0; n < 2; ++n)
#pragma unroll
                    for (int i = 0; i < 4; ++i) { const float gt = acc[ai][0][m][n][i], up = acc[ai][1][m][n][i]; v[n * 4 + i] = gt * sigmoidf_(gt) * up; }
                u32x4 o; o.x = pk2(v[0], v[1]); o.y = pk2(v[2], v[3]); o.z = pk2(v[4], v[5]); o.w = pk2(v[6], v[7]);
                *(u32x4*)rowp = o; }
    }
};
}

__device__ __forceinline__ void transpose_item(const float* __restrict__ W, int ldw, int ncols, int c0, int k0, bf16_t* dst, int ldd, LAS float* scr, int lane) {
    float tv[32]; const int cc = c0 + (lane & 31); const float* wp = W + (size_t)(k0 + (lane >> 5)) * ldw + cc;
#pragma unroll
    for (int i = 0; i < 32; ++i) tv[i] = (cc < ncols) ? wp[(size_t)(2 * i) * ldw] : 0.f;
#pragma unroll
    for (int i = 0; i < 32; ++i) scr[(2 * i + (lane >> 5)) * 33 + (lane & 31)] = tv[i];
    LDS_WAIT();
    const int c = lane & 7;
#pragma unroll
    for (int j = 0; j < 4; ++j) { const int n = (lane >> 3) + 8 * j; const LAS float* s = scr + (8 * c) * 33 + n;
        u32x4 o; o.x = pk2(s[0 * 33], s[1 * 33]); o.y = pk2(s[2 * 33], s[3 * 33]); o.z = pk2(s[4 * 33], s[5 * 33]); o.w = pk2(s[6 * 33], s[7 * 33]);
        *(u32x4*)(dst + (size_t)n * ldd + k0 + 8 * c) = o; }
    LDS_WAIT();
}
__device__ __forceinline__ void conv_plain(const float* W, int K, int N, int Npad, bf16_t* dst, LAS float* scr, int lane, int gw, int NGW) {
    const int nblk = Npad / 32, items = (K / 64) * nblk;
    for (int it = gw; it < items; it += NGW) { const int kb = it / nblk, nb = it % nblk;
        transpose_item(W, N, N, nb * 32, kb * 64, dst + (size_t)nb * 32 * K, K, scr, lane); }
}
__device__ __forceinline__ void conv_gateup(const float* Wg, const float* Wu, bf16_t* dst, LAS float* scr, int lane, int gw, int NGW) {
    const int nblk = (2 * FF_) / 32, items = (D_ / 64) * nblk;
    for (int it = gw; it < items; it += NGW) { const int kb = it / nblk, nb = it % nblk; const int n0 = nb * 32, tile = n0 >> 8, w = n0 & 255;
        const float* W = (w < 128) ? Wg : Wu; const int c0 = tile * 128 + (w & 127);
        transpose_item(W, FF_, FF_, c0, kb * 64, dst + (size_t)n0 * D_, D_, scr, lane); }
}
__device__ __forceinline__ void rms_row_to_bf16(const float* xrow, const float* g, bf16_t* orow, int lane) {
    const f32x4* xr = (const f32x4*)xrow + lane; const f32x4* gr = (const f32x4*)g + lane;
    f32x4 v[8]; float s = 0.f;
#pragma unroll
    for (int j = 0; j < 8; ++j) { v[j] = xr[64 * j]; s += (v[j].x * v[j].x + v[j].y * v[j].y) + (v[j].z * v[j].z + v[j].w * v[j].w); }
    const float rs = rsqrtf(wave_sum(s) * (1.f / D_) + EPS_);
    u32x2* o8 = (u32x2*)orow + lane;
#pragma unroll
    for (int j = 0; j < 8; ++j) { const f32x4 gg = gr[64 * j]; u32x2 o; o.x = pk2(v[j].x * rs * gg.x, v[j].y * rs * gg.y); o.y = pk2(v[j].z * rs * gg.z, v[j].w * rs * gg.w); o8[64 * j] = o; }
}
__device__ __forceinline__ void norm_phase(const float* hin, const bf16_t* Y, float coef, const float* g_post, float* hout, const float* g_pre, bf16_t* xn, int lane, int gw, int NGW) {
    for (int row = gw; row < S_; row += NGW) {
        const u32x2* yr = (const u32x2*)(Y + (size_t)row * D_) + lane; const f32x4* hr = (const f32x4*)(hin + (size_t)row * D_) + lane;
        const f32x4* gp = (const f32x4*)g_post + lane;
        f32x4 v[8]; float s = 0.f;
#pragma unroll
        for (int j = 0; j < 8; ++j) { const u32x2 w = yr[64 * j]; v[j].x = __uint_as_float(w.x << 16); v[j].y = __uint_as_float(w.x & 0xffff0000u); v[j].z = __uint_as_float(w.y << 16); v[j].w = __uint_as_float(w.y & 0xffff0000u);
            s += (v[j].x * v[j].x + v[j].y * v[j].y) + (v[j].z * v[j].z + v[j].w * v[j].w); }
        const float rs = rsqrtf(wave_sum(s) * (1.f / D_) + EPS_) * coef;
        f32x4* ho = (f32x4*)(hout + (size_t)row * D_) + lane;
        float s2 = 0.f;
#pragma unroll
        for (int j = 0; j < 8; ++j) { const f32x4 gg = gp[64 * j]; const f32x4 h = hr[64 * j];
            v[j].x = h.x + v[j].x * rs * gg.x; v[j].y = h.y + v[j].y * rs * gg.y; v[j].z = h.z + v[j].z * rs * gg.z; v[j].w = h.w + v[j].w * rs * gg.w;
            ho[64 * j] = v[j]; s2 += (v[j].x * v[j].x + v[j].y * v[j].y) + (v[j].z * v[j].z + v[j].w * v[j].w); }
        if (g_pre) {
            const float rs2 = rsqrtf(wave_sum(s2) * (1.f / D_) + EPS_);
            const f32x4* gq = (const f32x4*)g_pre + lane; u32x2* o8 = (u32x2*)(xn + (size_t)row * D_) + lane;
#pragma unroll
            for (int j = 0; j < 8; ++j) { const f32x4 gg = gq[64 * j]; u32x2 o; o.x = pk2(v[j].x * rs2 * gg.x, v[j].y * rs2 * gg.y); o.y = pk2(v[j].z * rs2 * gg.z, v[j].w * rs2 * gg.w); o8[64 * j] = o; }
        }
    }
}

__device__ __forceinline__ f32x4 wave_tile_gemm(const bf16_t* A, int lda, const bf16_t* Bt, int ldb, int K, int lane) {
    const bf16_t* ap = A + (size_t)(lane & 15) * lda + (lane >> 4) * 8; const bf16_t* bp = Bt + (size_t)(lane & 15) * ldb + (lane >> 4) * 8;
    f32x4 acc = {0.f, 0.f, 0.f, 0.f};
#pragma unroll 4
    for (int k = 0; k < K; k += 32) { const bf16x8 a = *(const bf16x8*)(ap + k), b = *(const bf16x8*)(bp + k); acc = __builtin_amdgcn_mfma_f32_16x16x32_bf16(a, b, acc, 0, 0, 0); }
    return acc;
}


__device__ __forceinline__ float tanhf_(float x) { const float e = __expf(2.f * x); return 1.f - 2.f * __builtin_amdgcn_rcpf(e + 1.f); }
__device__ __forceinline__ float gelu_tanh(float x) { return 0.5f * x * (1.f + tanhf_(0.7978845608f * (x + 0.044715f * x * x * x))); }
__device__ __forceinline__ bf16x8 pack8(const f32x4 a, const f32x4 b) { u32x4 o; o.x = pk2(a[0], a[1]); o.y = pk2(a[2], a[3]); o.z = pk2(b[0], b[1]); o.w = pk2(b[2], b[3]); return __builtin_bit_cast(bf16x8, o); }
__device__ __forceinline__ bf16x8 ld2x4(const bf16_t* p0, const bf16_t* p1) { const u32x2 a = *(const u32x2*)p0, b = *(const u32x2*)p1; u32x4 o; o.x = a.x; o.y = a.y; o.z = b.x; o.w = b.y; return __builtin_bit_cast(bf16x8, o); }
__device__ __forceinline__ float shiftv(const bf16_t* F, int t, int col, float mu) { const float f = bf2f(F[(size_t)t * IN_PAD + col]); const float fp = t > 0 ? bf2f(F[(size_t)(t - 1) * IN_PAD + col]) : 0.f; return f + mu * (fp - f); }

constexpr int C_R = 0, C_K = 1024, C_V = 2048, C_WD = 3072, C_Q = 3360, C_KC = 4384, C_VC = 4640, C_KS = 4896, C_VS = 5152, C_KW = 5408, C_VW = 5664, C_GL = 5920;

struct EpiLora {
    static constexpr bool PERM = true;
    bf16_t* O; const float* w0; const float* a0;
    __device__ __forceinline__ void operator()(const f32x4 (&acc)[2][2][4][2], const pg8::Unit& u, int wr, int wc, int fr, int fq) const {
        { int ln; asm volatile("v_mbcnt_lo_u32_b32 %0, -1, 0\n\tv_mbcnt_hi_u32_b32 %0, -1, %0" : "=v"(ln)); fr = ln & 15; fq = ln >> 4; }
        const int row0 = u.pm * 256 + wr * 64 + fr, col0 = u.pn * 256 + wc * 32 + 8 * fq; const int type = u.pn >> 2;
#pragma unroll
        for (int ai = 0; ai < 2; ++ai)
#pragma unroll
            for (int m = 0; m < 4; ++m) { bf16_t* rowp = O + (size_t)(row0 + ai * 128 + m * 16) * LORA_N + col0;
#pragma unroll
                for (int bj = 0; bj < 2; ++bj) { float v[8];
#pragma unroll
                    for (int n = 0; n < 2; ++n)
#pragma unroll
                        for (int i = 0; i < 4; ++i) { float x = acc[ai][bj][m][n][i]; const int c = (col0 + bj * 128 + n * 4 + i) & 1023;
                            if (type == 0) x = 0.60653066f * sigmoidf_(x + w0[c]); else if (type == 1) x = sigmoidf_(x + a0[c]);
                            v[n * 4 + i] = x; }
                    u32x4 o; o.x = pk2(v[0], v[1]); o.y = pk2(v[2], v[3]); o.z = pk2(v[4], v[5]); o.w = pk2(v[6], v[7]);
                    *(u32x4*)(rowp + bj * 128) = o; } }
    }
};

__device__ __forceinline__ void compress_task(const Params& p, unsigned char* ws, int task, int lane) {
    const int which = task >> 8, g = (task >> 6) & 3, n0 = (task & 63) * 16;
    const bf16_t* FE = (const bf16_t*)(ws + OFF_ACT);
    const bf16_t* W1T = (const bf16_t*)(ws + (which ? OFF_WC1V : OFF_WC1K));
    const bf16_t* W2T = (const bf16_t*)(ws + (which ? OFF_WC2V : OFF_WC2K));
    const float* pe = which ? p.in[23] : p.in[20];
    const int cb = (which ? C_VC : C_KC) + g * 64;
    const int col = lane & 15, quad = lane >> 4;
    int nn = n0 + col; if (nn > 1022) nn = 1022;
    f32x4 acc[8];
#pragma unroll
    for (int i = 0; i < 8; ++i) acc[i] = (f32x4){0.f, 0.f, 0.f, 0.f};
    for (int kt = 0; kt < 64; ++kt) {
        const int pp = kt >> 1, d = (kt & 1) * 32 + quad * 8;
        const bf16x8 xf = *(const bf16x8*)(FE + (size_t)(16 * nn + pp) * IN_PAD + cb + d);
        const f32x4 pa = *(const f32x4*)(pe + pp * 64 + d), pb = *(const f32x4*)(pe + pp * 64 + d + 4);
        const bf16x8 pf = pack8(pa, pb);
#pragma unroll
        for (int ct = 0; ct < 8; ++ct) { const bf16x8 wf = *(const bf16x8*)(W1T + (size_t)(ct * 16 + col) * 2048 + kt * 32 + quad * 8);
            acc[ct] = __builtin_amdgcn_mfma_f32_16x16x32_bf16(wf, xf, acc[ct], 0, 0, 0);
            acc[ct] = __builtin_amdgcn_mfma_f32_16x16x32_bf16(wf, pf, acc[ct], 0, 0, 0); }
    }
#pragma unroll
    for (int ct = 0; ct < 8; ++ct)
#pragma unroll
        for (int r = 0; r < 4; ++r) acc[ct][r] = gelu_tanh(acc[ct][r]);
    f32x4 o[4];
#pragma unroll
    for (int et = 0; et < 4; ++et) { o[et] = (f32x4){0.f, 0.f, 0.f, 0.f};
#pragma unroll
        for (int i = 0; i < 4; ++i) { const bf16x8 hf = pack8(acc[2 * i], acc[2 * i + 1]);
            const bf16_t* wr_ = W2T + (size_t)(et * 16 + col) * 128 + 32 * i + quad * 4;
            const bf16x8 wf = ld2x4(wr_, wr_ + 16);
            o[et] = __builtin_amdgcn_mfma_f32_16x16x32_bf16(wf, hf, o[et], 0, 0, 0); } }
    const int n = n0 + col;
    if (which == 0) { bf16_t* K = (bf16_t*)(ws + OFF_KCMP) + ((size_t)g * 64 + (n >> 4)) * 1024 + (n & 15) * 32;
#pragma unroll
        for (int et = 0; et < 4; ++et) { u32x2 v; v.x = pk2(o[et][0], o[et][1]); v.y = pk2(o[et][2], o[et][3]); *(u32x2*)(K + (et >> 1) * 512 + (et & 1) * 16 + quad * 4) = v; }
    } else { bf16_t* V = (bf16_t*)(ws + OFF_VCMPT) + ((size_t)g * 32 + (n >> 5)) * 2048 + ((n & 15) >> 2) * 8 + ((n >> 4) & 1) * 4 + (n & 3);
#pragma unroll
        for (int et = 0; et < 4; ++et)
#pragma unroll
            for (int r = 0; r < 4; ++r) V[et * 512 + (quad * 4 + r) * 32] = f2bf(o[et][r]);
    }
}

constexpr int SCAN_T = 32, SCAN_BUF_F = 5 * SCAN_T * 64 + SCAN_T * 16;
struct ScanRaw { float rr[9], kr[9], vr[9], uu[8], aa[8], nrm[8]; };
__device__ __forceinline__ void scan_fetch(ScanRaw& x, unsigned char* ws, int c, int head, int rbase, int lw, int lane) {
    const bf16_t* FE = (const bf16_t*)(ws + OFF_ACT); const bf16_t* LO = (const bf16_t*)(ws + OFF_LORA);
    const int cr = head * 64 + lane, vcol = C_V + head * 64 + rbase + (lane & 15), ta = c * SCAN_T + lw * 8;
#pragma unroll
    for (int i = 0; i < 9; ++i) { const int t = ta - 1 + i;
        if (t >= 0) { x.rr[i] = bf2f(FE[(size_t)t * IN_PAD + C_R + cr]); x.kr[i] = bf2f(FE[(size_t)t * IN_PAD + C_K + cr]); x.vr[i] = bf2f(FE[(size_t)t * IN_PAD + vcol]); }
        else { x.rr[i] = 0.f; x.kr[i] = 0.f; x.vr[i] = 0.f; } }
#pragma unroll
    for (int i = 0; i < 8; ++i) { const int t = ta + i; x.uu[i] = bf2f(LO[(size_t)t * LORA_N + cr]); x.aa[i] = bf2f(LO[(size_t)t * LORA_N + 1024 + cr]); x.nrm[i] = ((const float*)(ws + OFF_KN2))[t * 16 + head]; }
}
__device__ __forceinline__ void scan_emit(const ScanRaw& x, LAS float* buf, float mu_r, float mu_k, float mu_v, float kkw, float kaw, int lw, int lane) {
#pragma unroll
    for (int i = 0; i < 8; ++i) { const int tt = lw * 8 + i;
        const float r = x.rr[i + 1] + mu_r * (x.rr[i] - x.rr[i + 1]), k = x.kr[i + 1] + mu_k * (x.kr[i] - x.kr[i + 1]), v = x.vr[i + 1] + mu_v * (x.vr[i] - x.vr[i + 1]);
        const float a = x.aa[i], w = __expf(-x.uu[i]);
        const float kkn = k * kkw * x.nrm[i];
        buf[0 * SCAN_T * 64 + tt * 64 + lane] = w;
        buf[1 * SCAN_T * 64 + tt * 64 + lane] = -kkn;
        buf[2 * SCAN_T * 64 + tt * 64 + lane] = kkn * a;
        buf[3 * SCAN_T * 64 + tt * 64 + lane] = k * (1.f + (a - 1.f) * kaw);
        buf[4 * SCAN_T * 64 + tt * 64 + lane] = r;
        if (lane < 16) buf[5 * SCAN_T * 64 + tt * 16 + lane] = v; }
}
__device__ __forceinline__ void scan_step(float& s0, float& s1, float& s2, float& s3, const f32x4 NK, const f32x4 W, const f32x4 B, const f32x4 R,
                                          float t0, float t1, float t2, float t3, float& yp, float& yc) {
    float sa, tmp;
    asm volatile(
        "v_mul_f32 %[sa], %[s0], %[n0]\n\t"
        "v_mul_f32 %[tmp], %[s2], %[n2]\n\t"
        "v_fmac_f32 %[sa], %[s1], %[n1]\n\t"
        "v_fmac_f32 %[tmp], %[s3], %[n3]\n\t"
        "v_add_f32 %[sa], %[sa], %[tmp]\n\t"
        "s_nop 1\n\t"
        "v_add_f32_dpp %[sa], %[sa], %[sa] row_ror:8 row_mask:0xf bank_mask:0xf\n\t"
        "v_add_f32_dpp %[yp], %[yp], %[yp] row_ror:8 row_mask:0xf bank_mask:0xf\n\t"
        "s_nop 0\n\t"
        "v_add_f32_dpp %[sa], %[sa], %[sa] row_ror:4 row_mask:0xf bank_mask:0xf\n\t"
        "v_add_f32_dpp %[yp], %[yp], %[yp] row_ror:4 row_mask:0xf bank_mask:0xf\n\t"
        "s_nop 0\n\t"
        "v_add_f32_dpp %[sa], %[sa], %[sa] row_ror:2 row_mask:0xf bank_mask:0xf\n\t"
        "v_add_f32_dpp %[yp], %[yp], %[yp] row_ror:2 row_mask:0xf bank_mask:0xf\n\t"
        "s_nop 0\n\t"
        "v_add_f32_dpp %[sa], %[sa], %[sa] row_ror:1 row_mask:0xf bank_mask:0xf\n\t"
        "v_add_f32_dpp %[yp], %[yp], %[yp] row_ror:1 row_mask:0xf bank_mask:0xf\n\t"
        "v_fmac_f32 %[t0], %[sa], %[b0]\n\t"
        "v_fmac_f32 %[t1], %[sa], %[b1]\n\t"
        "v_fmac_f32 %[t2], %[sa], %[b2]\n\t"
        "v_fmac_f32 %[t3], %[sa], %[b3]\n\t"
        "v_fma_f32 %[s0], %[s0], %[w0], %[t0]\n\t"
        "v_fma_f32 %[s1], %[s1], %[w1], %[t1]\n\t"
        "v_fma_f32 %[s2], %[s2], %[w2], %[t2]\n\t"
        "v_fma_f32 %[s3], %[s3], %[w3], %[t3]\n\t"
        "v_mul_f32 %[yc], %[s0], %[r0]\n\t"
        "v_mul_f32 %[tmp], %[s2], %[r2]\n\t"
        "v_fmac_f32 %[yc], %[s1], %[r1]\n\t"
        "v_fmac_f32 %[tmp], %[s3], %[r3]\n\t"
        "v_add_f32 %[yc], %[yc], %[tmp]\n\t"
        : [s0] "+v"(s0), [s1] "+v"(s1), [s2] "+v"(s2), [s3] "+v"(s3), [t0] "+v"(t0), [t1] "+v"(t1), [t2] "+v"(t2), [t3] "+v"(t3),
          [yp] "+v"(yp), [yc] "=&v"(yc), [sa] "=&v"(sa), [tmp] "=&v"(tmp)
        : [n0] "v"(NK.x), [n1] "v"(NK.y), [n2] "v"(NK.z), [n3] "v"(NK.w), [w0] "v"(W.x), [w1] "v"(W.y), [w2] "v"(W.z), [w3] "v"(W.w),
          [b0] "v"(B.x), [b1] "v"(B.y), [b2] "v"(B.z), [b3] "v"(B.w), [r0] "v"(R.x), [r1] "v"(R.y), [r2] "v"(R.z), [r3] "v"(R.w));
}
__device__ __forceinline__ f32x2 scan_dot2(const f32x2 sA, const f32x2 sB, const f32x2 xA, const f32x2 xB) {
    f32x2 t;
    asm volatile("v_pk_mul_f32 %[t], %[sA], %[xA]\n\tv_pk_fma_f32 %[t], %[sB], %[xB], %[t]\n\t" : [t] "=&v"(t) : [sA] "v"(sA), [sB] "v"(sB), [xA] "v"(xA), [xB] "v"(xB));
    return t;
}
__device__ __forceinline__ void scan_reduce2(float& sa, float& yp) {
    asm volatile(
        "s_nop 1\n\t"
        "v_add_f32_dpp %[sa], %[sa], %[sa] row_ror:8 row_mask:0xf bank_mask:0xf\n\t"
        "v_add_f32_dpp %[yp], %[yp], %[yp] row_ror:8 row_mask:0xf bank_mask:0xf\n\t"
        "s_nop 0\n\t"
        "v_add_f32_dpp %[sa], %[sa], %[sa] row_ror:4 row_mask:0xf bank_mask:0xf\n\t"
        "v_add_f32_dpp %[yp], %[yp], %[yp] row_ror:4 row_mask:0xf bank_mask:0xf\n\t"
        "s_nop 0\n\t"
        "v_add_f32_dpp %[sa], %[sa], %[sa] row_ror:2 row_mask:0xf bank_mask:0xf\n\t"
        "v_add_f32_dpp %[yp], %[yp], %[yp] row_ror:2 row_mask:0xf bank_mask:0xf\n\t"
        "s_nop 0\n\t"
        "v_add_f32_dpp %[sa], %[sa], %[sa] row_ror:1 row_mask:0xf bank_mask:0xf\n\t"
        "v_add_f32_dpp %[yp], %[yp], %[yp] row_ror:1 row_mask:0xf bank_mask:0xf\n\t"
        "s_nop 1\n\t"
        : [sa] "+v"(sa), [yp] "+v"(yp));
}
__device__ __forceinline__ void scan_update2(f32x2& sA, f32x2& sB, const f32x2 wA, const f32x2 wB, const f32x2 bA, const f32x2 bB, const f32x2 kA, const f32x2 kB, const f32x2 sa2, const f32x2 vv2) {
    f32x2 uA, uB;
    asm volatile(
        "v_pk_mul_f32 %[uA], %[kA], %[vv2] op_sel_hi:[1,0]\n\t"
        "v_pk_mul_f32 %[uB], %[kB], %[vv2] op_sel_hi:[1,0]\n\t"
        "v_pk_fma_f32 %[uA], %[bA], %[sa2], %[uA] op_sel_hi:[1,0,1]\n\t"
        "v_pk_fma_f32 %[uB], %[bB], %[sa2], %[uB] op_sel_hi:[1,0,1]\n\t"
        "v_pk_fma_f32 %[sA], %[sA], %[wA], %[uA]\n\t"
        "v_pk_fma_f32 %[sB], %[sB], %[wB], %[uB]\n\t"
        : [sA] "+v"(sA), [sB] "+v"(sB), [uA] "=&v"(uA), [uB] "=&v"(uB)
        : [wA] "v"(wA), [wB] "v"(wB), [bA] "v"(bA), [bB] "v"(bB), [kA] "v"(kA), [kB] "v"(kB), [sa2] "v"(sa2), [vv2] "v"(vv2));
}
#define SCAN_BAR() do { asm volatile("s_waitcnt lgkmcnt(0)" ::: "memory"); __builtin_amdgcn_s_barrier(); asm volatile("" ::: "memory"); } while (0)
__device__ __forceinline__ void rwkv_scan_block(const Params& p, unsigned char* ws, LAS unsigned char* lds, int sb, int tid) {
    const int lane = tid & 63, wave = tid >> 6; const int head = sb >> 2, rbase = (sb & 3) * 16;
    LAS float* buf0 = (LAS float*)lds; LAS float* buf1 = buf0 + SCAN_BUF_F;
    bf16_t* YR = (bf16_t*)(ws + OFF_YRAW);
    const int cg_ = lane & 15, rl = (wave & 3) * 4 + (lane >> 4);
    constexpr int NCH = S_ / SCAN_T;
    if (wave >= 4) {
        const int lw = wave - 4; const int cr = head * 64 + lane, vcol = C_V + head * 64 + rbase + (lane & 15);
        const float mu_r = p.in[9][C_R + cr], mu_k = p.in[9][C_K + cr], mu_v = p.in[9][vcol], kkw = p.in[15][cr], kaw = p.in[16][cr];
        ScanRaw x; scan_fetch(x, ws, 0, head, rbase, lw, lane); scan_emit(x, buf0, mu_r, mu_k, mu_v, kkw, kaw, lw, lane); scan_fetch(x, ws, 1, head, rbase, lw, lane);
        SCAN_BAR();
        for (int c = 0; c < NCH; ++c) {
            if (c + 1 < NCH) scan_emit(x, (c & 1) ? buf0 : buf1, mu_r, mu_k, mu_v, kkw, kaw, lw, lane);
            if (c + 2 < NCH) scan_fetch(x, ws, c + 2, head, rbase, lw, lane);
            SCAN_BAR(); }
    } else {
        f32x2 sA = {0.f, 0.f}, sB = {0.f, 0.f};
        SCAN_BAR();
        for (int c = 0; c < NCH; ++c) {
            LAS float* cb = ((c & 1) ? buf1 : buf0) + cg_ * 4; LAS float* vb = ((c & 1) ? buf1 : buf0) + 5 * SCAN_T * 64 + rl;
#pragma unroll
            for (int hh = 0; hh < SCAN_T / 16; ++hh) {
                float ykeep = 0.f, yp = 0.f, yc = 0.f;
                f32x4 W = *(const LAS f32x4*)(cb + 0 * SCAN_T * 64 + hh * 1024), NK = *(const LAS f32x4*)(cb + 1 * SCAN_T * 64 + hh * 1024), B = *(const LAS f32x4*)(cb + 2 * SCAN_T * 64 + hh * 1024),
                      KP = *(const LAS f32x4*)(cb + 3 * SCAN_T * 64 + hh * 1024), R = *(const LAS f32x4*)(cb + 4 * SCAN_T * 64 + hh * 1024); float vv = vb[hh * 256];
#pragma unroll
                for (int ti = 0; ti < 16; ++ti) {
                    const int tn = hh * 16 + (ti < 15 ? ti + 1 : ti);
                    const f32x4 Wn = *(const LAS f32x4*)(cb + 0 * SCAN_T * 64 + tn * 64), NKn = *(const LAS f32x4*)(cb + 1 * SCAN_T * 64 + tn * 64), Bn = *(const LAS f32x4*)(cb + 2 * SCAN_T * 64 + tn * 64),
                                KPn = *(const LAS f32x4*)(cb + 3 * SCAN_T * 64 + tn * 64), Rn = *(const LAS f32x4*)(cb + 4 * SCAN_T * 64 + tn * 64); const float vn = vb[tn * 16];
                    const f32x2 d = scan_dot2(sA, sB, (f32x2){NK.x, NK.y}, (f32x2){NK.z, NK.w});
                    float sa = d.x + d.y; yp = yc;
                    scan_reduce2(sa, yp);
                    f32x2 sa2; sa2.x = sa; sa2.y = sa; f32x2 vv2; vv2.x = vv; vv2.y = vv;
                    scan_update2(sA, sB, (f32x2){W.x, W.y}, (f32x2){W.z, W.w}, (f32x2){B.x, B.y}, (f32x2){B.z, B.w}, (f32x2){KP.x, KP.y}, (f32x2){KP.z, KP.w}, sa2, vv2);
                    const f32x2 e = scan_dot2(sA, sB, (f32x2){R.x, R.y}, (f32x2){R.z, R.w});
                    yc = e.x + e.y;
                    if (ti >= 1) ykeep = (cg_ == ti - 1) ? yp : ykeep;
                    W = Wn; NK = NKn; B = Bn; KP = KPn; R = Rn; vv = vn;
                }
                const float y15 = rowsum16(yc);
                ykeep = (cg_ == 15) ? y15 : ykeep;
                YR[(size_t)(c * SCAN_T + hh * 16 + cg_) * 1024 + head * 64 + rbase + rl] = f2bf(ykeep);
            }
            SCAN_BAR(); }
    }
}

constexpr float QK_SCALE2 = 0.125f * 1.4426950408889634f;
struct Flash { float m, l; f32x4 o[4]; };
__device__ __forceinline__ void flash_init(Flash& f) { f.m = -1e30f; f.l = 0.f;
#pragma unroll
    for (int i = 0; i < 4; ++i) f.o[i] = (f32x4){0.f, 0.f, 0.f, 0.f}; }
struct KV64 { bf16x8 k[4][2]; bf16x8 v[2][4]; };
__device__ __forceinline__ void load_kv64(KV64& x, const bf16_t* Kp, const bf16_t* Vt, int kb, int col, int quad) {
#pragma unroll
    for (int a = 0; a < 4; ++a) { const bf16_t* kr = Kp + (size_t)((kb >> 4) + a) * 1024 + col * 32 + quad * 8; x.k[a][0] = *(const bf16x8*)kr; x.k[a][1] = *(const bf16x8*)(kr + 512); }
#pragma unroll
    for (int h = 0; h < 2; ++h)
#pragma unroll
        for (int dt = 0; dt < 4; ++dt) { const bf16_t* vr = Vt + (size_t)((kb >> 5) + h) * 2048 + dt * 512 + col * 32 + quad * 8; x.v[h][dt] = *(const bf16x8*)vr; }
}
__device__ __forceinline__ void flash_block64(Flash& f, const bf16x8 (&q)[2], const KV64& x, int kb, int lo, int hi, bool masked, int quad) {
    f32x4 s[4];
#pragma unroll
    for (int a = 0; a < 4; ++a) { s[a] = (f32x4){0.f, 0.f, 0.f, 0.f};
#pragma unroll
        for (int ks = 0; ks < 2; ++ks) s[a] = __builtin_amdgcn_mfma_f32_16x16x32_bf16(x.k[a][ks], q[ks], s[a], 0, 0, 0); }
    if (masked) {
#pragma unroll
        for (int a = 0; a < 4; ++a)
#pragma unroll
            for (int r = 0; r < 4; ++r) { const int key = kb + 16 * a + quad * 4 + r; s[a][r] = (key >= lo && key <= hi) ? s[a][r] : -1e30f; }
    }
    float mx = fmaxf(fmaxf(fmaxf(s[0][0], s[0][1]), fmaxf(s[0][2], s[0][3])), fmaxf(fmaxf(s[1][0], s[1][1]), fmaxf(s[1][2], s[1][3])));
    mx = fmaxf(mx, fmaxf(fmaxf(fmaxf(s[2][0], s[2][1]), fmaxf(s[2][2], s[2][3])), fmaxf(fmaxf(s[3][0], s[3][1]), fmaxf(s[3][2], s[3][3]))));
    mx = quad_allmax(mx) * QK_SCALE2;
    const float mn = fmaxf(f.m, mx);
    if (__ballot(mn != f.m) != 0ull) {
        const float alpha = __builtin_amdgcn_exp2f(f.m - mn); f.m = mn; f.l *= alpha;
#pragma unroll
        for (int dt = 0; dt < 4; ++dt) f.o[dt] *= alpha; }
    float ps = 0.f;
    if (masked) {
#pragma unroll
        for (int a = 0; a < 4; ++a)
#pragma unroll
            for (int r = 0; r < 4; ++r) { const float pv = s[a][r] > -1e29f ? __builtin_amdgcn_exp2f(__builtin_fmaf(s[a][r], QK_SCALE2, -mn)) : 0.f; s[a][r] = pv; ps += pv; }
    } else {
#pragma unroll
        for (int a = 0; a < 4; ++a)
#pragma unroll
            for (int r = 0; r < 4; ++r) { const float pv = __builtin_amdgcn_exp2f(__builtin_fmaf(s[a][r], QK_SCALE2, -mn)); s[a][r] = pv; ps += pv; }
    }
    f.l += ps;
    const bf16x8 p0 = pack8(s[0], s[1]), p1 = pack8(s[2], s[3]);
#pragma unroll
    for (int dt = 0; dt < 4; ++dt) { f.o[dt] = __builtin_amdgcn_mfma_f32_16x16x32_bf16(x.v[0][dt], p0, f.o[dt], 0, 0, 0); f.o[dt] = __builtin_amdgcn_mfma_f32_16x16x32_bf16(x.v[1][dt], p1, f.o[dt], 0, 0, 0); }
}
__device__ __forceinline__ void flash_block64v(Flash& f, const bf16x8 (&q)[2], const KV64& x, bool valid) {
    f32x4 s[4];
#pragma unroll
    for (int a = 0; a < 4; ++a) { s[a] = (f32x4){0.f, 0.f, 0.f, 0.f};
#pragma unroll
        for (int ks = 0; ks < 2; ++ks) s[a] = __builtin_amdgcn_mfma_f32_16x16x32_bf16(x.k[a][ks], q[ks], s[a], 0, 0, 0); }
    float mx = fmaxf(fmaxf(fmaxf(s[0][0], s[0][1]), fmaxf(s[0][2], s[0][3])), fmaxf(fmaxf(s[1][0], s[1][1]), fmaxf(s[1][2], s[1][3])));
    mx = fmaxf(mx, fmaxf(fmaxf(fmaxf(s[2][0], s[2][1]), fmaxf(s[2][2], s[2][3])), fmaxf(fmaxf(s[3][0], s[3][1]), fmaxf(s[3][2], s[3][3]))));
    mx = valid ? quad_allmax(mx) * QK_SCALE2 : f.m;
    const float mn = fmaxf(f.m, mx);
    if (__ballot(mn != f.m) != 0ull) {
        const float alpha = __builtin_amdgcn_exp2f(f.m - mn); f.m = mn; f.l *= alpha;
#pragma unroll
        for (int dt = 0; dt < 4; ++dt) f.o[dt] *= alpha; }
    float ps = 0.f;
#pragma unroll
    for (int a = 0; a < 4; ++a)
#pragma unroll
        for (int r = 0; r < 4; ++r) { const float pv = __builtin_amdgcn_exp2f(__builtin_fmaf(s[a][r], QK_SCALE2, -mn)); s[a][r] = pv; ps += pv; }
    f.l += valid ? ps : 0.f;
    const unsigned vm = valid ? 0xffffffffu : 0u;
    u32x4 p0 = __builtin_bit_cast(u32x4, pack8(s[0], s[1])), p1 = __builtin_bit_cast(u32x4, pack8(s[2], s[3]));
    p0.x &= vm; p0.y &= vm; p0.z &= vm; p0.w &= vm; p1.x &= vm; p1.y &= vm; p1.z &= vm; p1.w &= vm;
    const bf16x8 b0 = __builtin_bit_cast(bf16x8, p0), b1 = __builtin_bit_cast(bf16x8, p1);
#pragma unroll
    for (int dt = 0; dt < 4; ++dt) { f.o[dt] = __builtin_amdgcn_mfma_f32_16x16x32_bf16(x.v[0][dt], b0, f.o[dt], 0, 0, 0); f.o[dt] = __builtin_amdgcn_mfma_f32_16x16x32_bf16(x.v[1][dt], b1, f.o[dt], 0, 0, 0); }
}
__device__ __forceinline__ float flash_finish(const Flash& f) { const float l = quad_allsum(f.l); return l > 0.f ? 1.f / l : 0.f; }

constexpr int NSA_WLDS = 10240;

__device__ __forceinline__ void nsa_q(const bf16_t* FE, const float* ROPE, int tcol, int head, int quad, bf16x8 (&qn)[2], bf16x8 (&qr)[2]) {
    const bf16_t* qrow = FE + (size_t)tcol * IN_PAD + C_Q + head * 64;
    qn[0] = *(const bf16x8*)(qrow + quad * 8); qn[1] = *(const bf16x8*)(qrow + 32 + quad * 8);
    qr[0] = qn[0]; qr[1] = qn[1];
    if (quad < 2) { const bf16x8 ot = *(const bf16x8*)(qrow + (quad ^ 1) * 8); const float* cs = ROPE + (size_t)tcol * 16; float v[8];
#pragma unroll
        for (int i = 0; i < 8; ++i) { const float x = bf2f((bf16_t)qn[0][i]), y = bf2f((bf16_t)ot[i]); v[i] = quad == 0 ? x * cs[i] - y * cs[8 + i] : x * cs[i] + y * cs[8 + i]; }
        u32x4 o; o.x = pk2(v[0], v[1]); o.y = pk2(v[2], v[3]); o.z = pk2(v[4], v[5]); o.w = pk2(v[6], v[7]); qr[0] = __builtin_bit_cast(bf16x8, o); }
}
__device__ __forceinline__ void nsa_tile_pre(unsigned char* ws, LAS unsigned char* wl, LAS unsigned* blkmask, LAS unsigned char* kvb, int tid, int ncb, int t0, int g, int lane, f32x4 (&oc)[4]) {
    const bf16_t* FE = (const bf16_t*)(ws + OFF_ACT);
    LAS float* impA = (LAS float*)wl; LAS float* impB = impA + 1024; LAS int* sel = (LAS int*)(impB + 1024);
    const int col = lane & 15, quad = lane >> 4, tok = col >> 2, hl = col & 3, head = g * 4 + hl, tcol = t0 + tok;
    bf16x8 qn[2];
    { const bf16_t* qrow = FE + (size_t)tcol * IN_PAD + C_Q + head * 64; qn[0] = *(const bf16x8*)(qrow + quad * 8); qn[1] = *(const bf16x8*)(qrow + 32 + quad * 8); }
    const int nmax_col = tcol >= 31 ? (tcol - 31) >> 4 : -1;
    const bf16_t* KC = (const bf16_t*)(ws + OFF_KCMP) + (size_t)g * 1024 * 64;
    const bf16_t* VCT = (const bf16_t*)(ws + OFF_VCMPT) + (size_t)g * 64 * 1024;
    float ml = -1e30f, ll = 0.f;
    __syncthreads();
    { const u32x4 k0 = *(const u32x4*)(KC + tid * 8); *(LAS u32x4*)(kvb + tid * 16) = k0; }
    u32x4 rkA = {0u, 0u, 0u, 0u}, rkB = rkA, rvA = rkA, rvB = rkA;
    if (1 < ncb) rkA = *(const u32x4*)(KC + (size_t)1 * 4096 + tid * 8);
    if (2 < ncb) rkB = *(const u32x4*)(KC + (size_t)2 * 4096 + tid * 8);
    __syncthreads();
#define CMP1_STEP(jc, RK) if ((jc) < ncb) { \
        LAS unsigned char* cb = kvb + ((jc) & 1) * 16384; LAS unsigned char* nb = kvb + (((jc) + 1) & 1) * 16384; \
        _Pragma("unroll") for (int hf = 0; hf < 2; ++hf) { const int kb = (jc) * 64 + hf * 32; float sv[8]; float mx = -1e30f; \
            _Pragma("unroll") for (int a = 0; a < 2; ++a) { f32x4 s = {0.f, 0.f, 0.f, 0.f}; \
                _Pragma("unroll") for (int ks = 0; ks < 2; ++ks) { const bf16x8 kf = *(const LAS bf16x8*)(cb + (((2 * hf + a) * 2 + ks) * 512 + col * 32 + quad * 8) * 2); s = __builtin_amdgcn_mfma_f32_16x16x32_bf16(kf, qn[ks], s, 0, 0, 0); } \
                _Pragma("unroll") for (int r = 0; r < 4; ++r) { const int n = kb + 16 * a + quad * 4 + r; sv[a * 4 + r] = n <= nmax_col ? s[r] * QK_SCALE2 : -1e30f; mx = fmaxf(mx, sv[a * 4 + r]); } } \
            const float mn = fmaxf(ml, mx); float ps = 0.f; \
            _Pragma("unroll") for (int i = 0; i < 8; ++i) ps += sv[i] > -1e29f ? __builtin_amdgcn_exp2f(sv[i] - mn) : 0.f; \
            ll = ll * __builtin_amdgcn_exp2f(ml - mn) + ps; ml = mn; } \
        if ((jc) + 1 < ncb) *(LAS u32x4*)(nb + tid * 16) = RK; \
        if ((jc) + 3 < ncb) RK = *(const u32x4*)(KC + (size_t)((jc) + 3) * 4096 + tid * 8); \
        SCAN_BAR(); }
    for (int jc = 0; jc < ncb; jc += 2) { CMP1_STEP(jc, rkA) CMP1_STEP(jc + 1, rkB) }
#undef CMP1_STEP
    const float M = quad_allmax(ml);
    const float L = quad_allsum(ll * __builtin_amdgcn_exp2f(ml - M));
    const float invL = L > 0.f ? 1.f / L : 0.f;
#pragma unroll
    for (int i = 0; i < 32; ++i) impA[i * 64 + lane] = 0.f;
    LDS_WAIT();
#pragma unroll
    for (int i = 0; i < 4; ++i) oc[i] = (f32x4){0.f, 0.f, 0.f, 0.f};
    __syncthreads();
    { const u32x4 k0 = *(const u32x4*)(KC + tid * 8), v0 = *(const u32x4*)(VCT + tid * 8); *(LAS u32x4*)(kvb + tid * 16) = k0; *(LAS u32x4*)(kvb + 8192 + tid * 16) = v0; }
    if (1 < ncb) { rkA = *(const u32x4*)(KC + (size_t)1 * 4096 + tid * 8); rvA = *(const u32x4*)(VCT + (size_t)1 * 4096 + tid * 8); }
    if (2 < ncb) { rkB = *(const u32x4*)(KC + (size_t)2 * 4096 + tid * 8); rvB = *(const u32x4*)(VCT + (size_t)2 * 4096 + tid * 8); }
    __syncthreads();
#define CMP2_STEP(jc, RK, RV) if ((jc) < ncb) { \
        LAS unsigned char* cb = kvb + ((jc) & 1) * 16384; LAS unsigned char* nb = kvb + (((jc) + 1) & 1) * 16384; \
        _Pragma("unroll") for (int hf = 0; hf < 2; ++hf) { const int kb = (jc) * 64 + hf * 32; f32x4 pr[2]; \
            _Pragma("unroll") for (int a = 0; a < 2; ++a) { f32x4 s = {0.f, 0.f, 0.f, 0.f}; \
                _Pragma("unroll") for (int ks = 0; ks < 2; ++ks) { const bf16x8 kf = *(const LAS bf16x8*)(cb + (((2 * hf + a) * 2 + ks) * 512 + col * 32 + quad * 8) * 2); s = __builtin_amdgcn_mfma_f32_16x16x32_bf16(kf, qn[ks], s, 0, 0, 0); } \
                _Pragma("unroll") for (int r = 0; r < 4; ++r) { const int n = kb + 16 * a + quad * 4 + r; pr[a][r] = n <= nmax_col ? __builtin_amdgcn_exp2f(s[r] * QK_SCALE2 - M) * invL : 0.f; } } \
            const bf16x8 pf = pack8(pr[0], pr[1]); \
            _Pragma("unroll") for (int dt = 0; dt < 4; ++dt) { const bf16x8 vf = *(const LAS bf16x8*)(cb + 8192 + (hf * 2048 + dt * 512 + col * 32 + quad * 8) * 2); \
                oc[dt] = __builtin_amdgcn_mfma_f32_16x16x32_bf16(vf, pf, oc[dt], 0, 0, 0); } \
            _Pragma("unroll") for (int a = 0; a < 2; ++a) { float s4 = (pr[a][0] + pr[a][1]) + (pr[a][2] + pr[a][3]), p3 = pr[a][3]; \
                s4 += dppf<0xB1>(s4); s4 += dppf<0x4E>(s4); p3 += dppf<0xB1>(p3); p3 += dppf<0x4E>(p3); \
                const int jj = ((kb + 16 * a) >> 2) + quad; \
                if (hl == 0 && jj < 256) { impA[tok * 256 + jj] = s4; if (jj + 1 < 256) impB[tok * 256 + jj + 1] = p3; } } } \
        if ((jc) + 1 < ncb) { *(LAS u32x4*)(nb + tid * 16) = RK; *(LAS u32x4*)(nb + 8192 + tid * 16) = RV; } \
        if ((jc) + 3 < ncb) { RK = *(const u32x4*)(KC + (size_t)((jc) + 3) * 4096 + tid * 8); RV = *(const u32x4*)(VCT + (size_t)((jc) + 3) * 4096 + tid * 8); } \
        SCAN_BAR(); }
    for (int jc = 0; jc < ncb; jc += 2) { CMP2_STEP(jc, rkA, rvA) CMP2_STEP(jc + 1, rkB, rvB) }
#undef CMP2_STEP
    LDS_WAIT();
    for (int tk = 0; tk < 4; ++tk) { const int t = t0 + tk, cur = t >> 6; int cnt = 0;
        if (lane == 0) { sel[tk * 16 + 0] = 0; if (cur >= 1) sel[tk * 16 + 1] = cur; if (cur >= 2) sel[tk * 16 + 2] = cur - 1; }
        cnt = cur == 0 ? 1 : (cur == 1 ? 2 : 3);
        const int ncand = cur >= 2 ? cur - 2 : 0, nfree = 16 - cnt;
        if (ncand <= nfree) { if (lane < ncand) sel[tk * 16 + cnt + lane] = 1 + lane; cnt += ncand; }
        else {
            unsigned v[4];
#pragma unroll
            for (int i = 0; i < 4; ++i) { const int j = lane * 4 + i; v[i] = (j >= 1 && j <= cur - 2) ? ((__float_as_uint(impA[tk * 256 + j] + impB[tk * 256 + j]) & 0xFFFFFF00u) | (unsigned)(255 - j)) : 0u; }
            const int ti_ = (t0 & 63) + tk; LAS unsigned* mrow = blkmask + (ti_ >> 5); const unsigned bit_ = 1u << (ti_ & 31);
            for (int rd = 0; rd < nfree; ++rd) {
                const unsigned wm = wave_max_u(umax_(umax_(v[0], v[1]), umax_(v[2], v[3])));
#pragma unroll
                for (int i = 0; i < 4; ++i) v[i] = (v[i] == wm) ? 0u : v[i];
                const int bj = 255 - (int)(__builtin_amdgcn_readfirstlane(wm) & 0xFFu);
                if (lane == 0) __hip_atomic_fetch_or(mrow + 2 * bj, bit_, __ATOMIC_RELAXED, __HIP_MEMORY_SCOPE_WORKGROUP); } }
        LDS_WAIT();
        if (lane < cnt) { const int j = sel[tk * 16 + lane]; const int ti = (t0 & 63) + tk;
            __hip_atomic_fetch_or(blkmask + 2 * j + (ti >> 5), 1u << (ti & 31), __ATOMIC_RELAXED, __HIP_MEMORY_SCOPE_WORKGROUP); } }
    LDS_WAIT();
}
__device__ __forceinline__ void nsa_tile_add(unsigned char* ws, int t0, int g, int lane, const Flash& fb, int gi) {
    const bf16_t* FE = (const bf16_t*)(ws + OFF_ACT);
    const int col = lane & 15, quad = lane >> 4, tok = col >> 2, hl = col & 3, head = g * 4 + hl, tcol = t0 + tok;
    const float gb = sigmoidf_(bf2f(FE[(size_t)tcol * IN_PAD + C_GL + gi + head])) * flash_finish(fb);
    bf16_t* yo = (bf16_t*)(ws + OFF_XN) + (size_t)tcol * D_ + 1024 + head * 64 + quad * 4;
#pragma unroll
    for (int dt = 0; dt < 4; ++dt) { const u32x2 pc = *(const u32x2*)(yo + dt * 16);
        f32x4 o = gb * fb.o[dt];
        o[0] += __uint_as_float(pc.x << 16); o[1] += __uint_as_float(pc.x & 0xffff0000u); o[2] += __uint_as_float(pc.y << 16); o[3] += __uint_as_float(pc.y & 0xffff0000u);
        u32x2 v; v.x = pk2(o[0], o[1]); v.y = pk2(o[2], o[3]); *(u32x2*)(yo + dt * 16) = v; }
}
constexpr int NI_MASK = 0, NI_ID = 2048, NI_KV = 4096, NI_KVB = 4096 + 8 * NSA_WLDS;
__device__ __forceinline__ void nsa_item(unsigned char* ws, LAS unsigned char* lds, int qb, int g, int wave, int lane) {
    asm volatile("" : "+v"(lane));
    const bf16_t* FE = (const bf16_t*)(ws + OFF_ACT); const float* ROPE = (const float*)(ws + OFF_ROPE);
    LAS unsigned* blkmask = (LAS unsigned*)(lds + NI_MASK);
    LAS unsigned char* wl = lds + NI_KV + wave * NSA_WLDS;
    const int tid = wave * 64 + lane, col = lane & 15, quad = lane >> 4, tok = col >> 2, hl = col & 3, head = g * 4 + hl;
    const int tw = qb * 64 + wave * 8;
    blkmask[tid] = 0u;
    __syncthreads();
    for (int c = 0; c < 2; ++c) {
        f32x4 oc[4]; const int t0 = tw + 4 * c;
        nsa_tile_pre(ws, wl, blkmask, lds + NI_KVB, tid, ((4 * qb + 2) >> 6) + 1, t0, g, lane, oc);
        const float gc = sigmoidf_(bf2f(FE[(size_t)(t0 + tok) * IN_PAD + C_GL + head]));
        bf16_t* yo = (bf16_t*)(ws + OFF_XN) + (size_t)(t0 + tok) * D_ + 1024 + head * 64 + quad * 4;
#pragma unroll
        for (int dt = 0; dt < 4; ++dt) { u32x2 v; v.x = pk2(gc * oc[dt][0], gc * oc[dt][1]); v.y = pk2(gc * oc[dt][2], gc * oc[dt][3]); *(u32x2*)(yo + dt * 16) = v; } }
    __syncthreads();
    const bf16_t* KS = (const bf16_t*)(ws + OFF_KSR) + (size_t)g * S_ * 64;
    const bf16_t* VS = (const bf16_t*)(ws + OFF_VST) + (size_t)g * S_ * 64;
    LAS unsigned char* kvb = lds + NI_KVB;
    {
        bf16x8 qn[2], qr0[2], qr1[2];
        nsa_q(FE, ROPE, tw + tok, head, quad, qn, qr0);
        nsa_q(FE, ROPE, tw + 4 + tok, head, quad, qn, qr1);
        Flash f0, f1; flash_init(f0); flash_init(f1);
        __syncthreads();
        { const u32x4 k0 = *(const u32x4*)(KS + tid * 8), v0 = *(const u32x4*)(VS + tid * 8);
          *(LAS u32x4*)(kvb + tid * 16) = k0; *(LAS u32x4*)(kvb + 8192 + tid * 16) = v0; }
        u32x4 rk = {0u, 0u, 0u, 0u}, rv = rk;
        __syncthreads();
        for (int j = 0; j <= qb; ++j) {
            LAS unsigned char* cb = kvb + (j & 1) * 16384; LAS unsigned char* nb = kvb + ((j + 1) & 1) * 16384;
            if (j < qb) { rk = *(const u32x4*)(KS + (size_t)(j + 1) * 4096 + tid * 8); rv = *(const u32x4*)(VS + (size_t)(j + 1) * 4096 + tid * 8); }
            unsigned my8 = 0xFFu;
            if (j < qb) { const unsigned mw = __builtin_amdgcn_readfirstlane(blkmask[2 * j + (wave >> 2)]); my8 = (mw >> ((wave & 3) * 8)) & 0xFFu; }
            if (my8) {
                KV64 x;
#pragma unroll
                for (int a = 0; a < 4; ++a)
#pragma unroll
                    for (int ks = 0; ks < 2; ++ks) x.k[a][ks] = *(const LAS bf16x8*)(cb + ((a * 2 + ks) * 512 + col * 32 + quad * 8) * 2);
#pragma unroll
                for (int h = 0; h < 2; ++h)
#pragma unroll
                    for (int dt = 0; dt < 4; ++dt) x.v[h][dt] = *(const LAS bf16x8*)(cb + 8192 + (h * 2048 + dt * 512 + col * 32 + quad * 8) * 2);
                const unsigned b0 = my8 & 0xFu, b1 = my8 >> 4;
                if (j < qb) { if (b0) flash_block64v(f0, qr0, x, (b0 >> tok) & 1u); if (b1) flash_block64v(f1, qr1, x, (b1 >> tok) & 1u); }
                else { flash_block64(f0, qr0, x, qb * 64, 0, tw + tok, true, quad); flash_block64(f1, qr1, x, qb * 64, 0, tw + 4 + tok, true, quad); }
            }
            if (j < qb) { *(LAS u32x4*)(nb + tid * 16) = rk; *(LAS u32x4*)(nb + 8192 + tid * 16) = rv; }
            SCAN_BAR();
        }
        nsa_tile_add(ws, tw, g, lane, f0, 16); nsa_tile_add(ws, tw + 4, g, lane, f1, 16);
        flash_init(f0); flash_init(f1);
        { const bf16_t* KW = (const bf16_t*)(ws + OFF_KWR) + (size_t)g * S_ * 64;
          const bf16_t* VW = (const bf16_t*)(ws + OFF_VWT) + (size_t)g * S_ * 64;
          const int jw0 = qb >= 8 ? qb - 8 : 0;
          __syncthreads();
          rk = *(const u32x4*)(KW + (size_t)jw0 * 4096 + tid * 8); rv = *(const u32x4*)(VW + (size_t)jw0 * 4096 + tid * 8);
          *(LAS u32x4*)(kvb + (jw0 & 1) * 16384 + tid * 16) = rk; *(LAS u32x4*)(kvb + (jw0 & 1) * 16384 + 8192 + tid * 16) = rv;
          __syncthreads();
          for (int j = jw0; j <= qb; ++j) {
              LAS unsigned char* cb = kvb + (j & 1) * 16384; LAS unsigned char* nb = kvb + ((j + 1) & 1) * 16384;
              if (j < qb) { rk = *(const u32x4*)(KW + (size_t)(j + 1) * 4096 + tid * 8); rv = *(const u32x4*)(VW + (size_t)(j + 1) * 4096 + tid * 8); }
              KV64 x;
#pragma unroll
              for (int a = 0; a < 4; ++a)
#pragma unroll
                  for (int ks = 0; ks < 2; ++ks) x.k[a][ks] = *(const LAS bf16x8*)(cb + ((a * 2 + ks) * 512 + col * 32 + quad * 8) * 2);
#pragma unroll
              for (int h = 0; h < 2; ++h)
#pragma unroll
                  for (int dt = 0; dt < 4; ++dt) x.v[h][dt] = *(const LAS bf16x8*)(cb + 8192 + (h * 2048 + dt * 512 + col * 32 + quad * 8) * 2);
              if (j == qb || j + 8 == qb) { flash_block64(f0, qr0, x, j * 64, tw + tok - 511, tw + tok, true, quad); flash_block64(f1, qr1, x, j * 64, tw + 4 + tok - 511, tw + 4 + tok, true, quad); }
              else { flash_block64v(f0, qr0, x, true); flash_block64v(f1, qr1, x, true); }
              if (j < qb) { *(LAS u32x4*)(nb + tid * 16) = rk; *(LAS u32x4*)(nb + 8192 + tid * 16) = rv; }
              SCAN_BAR();
          } }
        nsa_tile_add(ws, tw, g, lane, f0, 32); nsa_tile_add(ws, tw + 4, g, lane, f1, 32);
    }
}

__device__ __forceinline__ void mem_attn_task(unsigned char* ws, int task, int lane) {
    const int h = task & 3, t0 = (task >> 2) * 16, col = lane & 15, quad = lane >> 4;
    const bf16_t* QM = (const bf16_t*)(ws + OFF_QM); const bf16_t* KM = (const bf16_t*)(ws + OFF_KM); const bf16_t* VMT = (const bf16_t*)(ws + OFF_VMT);
    bf16x8 q[4];
#pragma unroll
    for (int ks = 0; ks < 4; ++ks) q[ks] = *(const bf16x8*)(QM + (size_t)(t0 + col) * 512 + h * 128 + ks * 32 + quad * 8);
    float m = -1e30f, l = 0.f; f32x4 o[8];
#pragma unroll
    for (int i = 0; i < 8; ++i) o[i] = (f32x4){0.f, 0.f, 0.f, 0.f};
    const float sc = 0.08838834764831845f;
    for (int kb = 0; kb < 256; kb += 32) { f32x4 s[2]; float mx = -1e30f;
#pragma unroll
        for (int a = 0; a < 2; ++a) { s[a] = (f32x4){0.f, 0.f, 0.f, 0.f}; const bf16_t* kr = KM + (size_t)(kb + 16 * a + col) * 512 + h * 128 + quad * 8;
#pragma unroll
            for (int ks = 0; ks < 4; ++ks) { const bf16x8 kf = *(const bf16x8*)(kr + ks * 32); s[a] = __builtin_amdgcn_mfma_f32_16x16x32_bf16(kf, q[ks], s[a], 0, 0, 0); }
#pragma unroll
            for (int r = 0; r < 4; ++r) { s[a][r] *= sc; mx = fmaxf(mx, s[a][r]); } }
        mx = fmaxf(mx, __shfl_xor(mx, 16)); mx = fmaxf(mx, __shfl_xor(mx, 32));
        const float mn = fmaxf(m, mx), alpha = __expf(m - mn); m = mn; float ps = 0.f;
#pragma unroll
        for (int a = 0; a < 2; ++a)
#pragma unroll
            for (int r = 0; r < 4; ++r) { s[a][r] = __expf(s[a][r] - mn); ps += s[a][r]; }
        l = l * alpha + ps;
        const bf16x8 pf = pack8(s[0], s[1]);
#pragma unroll
        for (int dt = 0; dt < 8; ++dt) { const bf16_t* vr = VMT + (size_t)(h * 128 + dt * 16 + col) * 256 + kb + quad * 4; const bf16x8 vf = ld2x4(vr, vr + 16);
            o[dt] *= alpha; o[dt] = __builtin_amdgcn_mfma_f32_16x16x32_bf16(vf, pf, o[dt], 0, 0, 0); } }
    l += __shfl_xor(l, 16); l += __shfl_xor(l, 32); const float inv = 1.f / l;
    bf16_t* om = (bf16_t*)(ws + OFF_OM) + (size_t)(t0 + col) * 512 + h * 128 + quad * 4;
#pragma unroll
    for (int dt = 0; dt < 8; ++dt) { u32x2 v; v.x = pk2(o[dt][0] * inv, o[dt][1] * inv); v.y = pk2(o[dt][2] * inv, o[dt][3] * inv); *(u32x2*)(om + dt * 16) = v; }
}


__device__ __forceinline__ void gsync(unsigned* bar, unsigned target, int wave_s) {
    asm volatile("s_waitcnt vmcnt(0) lgkmcnt(0)" ::: "memory");
    __syncthreads();
    if (wave_s == 0) { int lane; asm volatile("v_mbcnt_lo_u32_b32 %0, -1, 0\n\tv_mbcnt_hi_u32_b32 %0, -1, %0" : "=v"(lane));
        if (lane == 0) { __builtin_amdgcn_fence(__ATOMIC_RELEASE, "agent");
            asm volatile("s_waitcnt vmcnt(0)" ::: "memory");
            __hip_atomic_fetch_add(bar, 1u, __ATOMIC_RELAXED, __HIP_MEMORY_SCOPE_AGENT);
            while (__hip_atomic_load(bar, __ATOMIC_RELAXED, __HIP_MEMORY_SCOPE_AGENT) < target) __builtin_amdgcn_s_sleep(20); } }
    __syncthreads();
    __builtin_amdgcn_fence(__ATOMIC_ACQUIRE, "agent");
    asm volatile("s_waitcnt vmcnt(0)" ::: "memory");
}
__device__ __forceinline__ void ffn_phases(unsigned* bar, unsigned& bar_t, LAS unsigned char* lds, unsigned char* ws, bf16_t* XN, bf16_t* ACT, bf16_t* Y, int G, int bid, const int wave_s) {
    { pg8::StaticOrder so; so.init(S_, 2 * FF_, G, bid);
      pg8::Gemm g{XN, (const bf16_t*)(ws + OFF_WGU), S_, 2 * FF_, D_};
      pg8::EpiSwiGLU e{ACT, FF_};
      pg8::gemm_phase(lds, g, so, e, wave_s); }
    bar_t += G; gsync(bar, bar_t, wave_s);
    { pg8::StaticOrder so; so.init(S_, D_, G, bid);
      pg8::Gemm g{ACT, (const bf16_t*)(ws + OFF_WD), S_, D_, FF_};
      pg8::EpiBf16 e{Y, D_};
      pg8::gemm_phase(lds, g, so, e, wave_s); }
    bar_t += G; gsync(bar, bar_t, wave_s);
}

__global__ void __launch_bounds__(512, 2) hymba_fwd(Params p) {
    extern __shared__ __attribute__((aligned(16))) unsigned char shm[];
    cg::grid_group grid = cg::this_grid();
    LAS unsigned char* lds = (LAS unsigned char*)shm;
    const int G = gridDim.x, bid = blockIdx.x;
    const int NGW = G * 8, NT = G * 512;
    unsigned char* ws = p.ws;
    bf16_t* XN = (bf16_t*)(ws + OFF_XN);
    bf16_t* ACT = (bf16_t*)(ws + OFF_ACT);
    bf16_t* Y = (bf16_t*)(ws + OFF_Y);
    unsigned* ctr = (unsigned*)(ws + OFF_CTR);
    unsigned* bar = ctr + 64; unsigned bar_t = 0;
    const int wave_s = __builtin_amdgcn_readfirstlane(threadIdx.x >> 6);
#define PHASE_IDX() int lane; asm volatile("v_mbcnt_lo_u32_b32 %0, -1, 0\n\tv_mbcnt_hi_u32_b32 %0, -1, %0" : "=v"(lane)); const int wave = wave_s; const int tid = wave * 64 + lane; (void)tid; const int gw = bid * 8 + wave, gtid = bid * 512 + tid; (void)gtid; (void)gw; (void)lane; LAS float* scr = (LAS float*)(lds + wave * 16384); (void)scr;

    {
        PHASE_IDX();
        conv_gateup(p.in[3], p.in[4], (bf16_t*)(ws + OFF_WGU), scr, lane, gw, NGW);
        conv_plain(p.in[5], FF_, D_, D_, (bf16_t*)(ws + OFF_WD), scr, lane, gw, NGW);
        conv_plain(p.in[8], D_, IN_COLS, IN_PAD, (bf16_t*)(ws + OFF_WIN), scr, lane, gw, NGW);
        conv_plain(p.in[26], D_, D_, D_, (bf16_t*)(ws + OFF_WOUT), scr, lane, gw, NGW);
        conv_plain(p.in[30], D_, 512, 512, (bf16_t*)(ws + OFF_WMQ), scr, lane, gw, NGW);
        conv_plain(p.in[32], 512, D_, D_, (bf16_t*)(ws + OFF_WMO), scr, lane, gw, NGW);
        conv_plain(p.in[31], D_, 1024, 1024, (bf16_t*)(ws + OFF_WMKV), scr, lane, gw, NGW);
        conv_plain(p.in[21], 2048, 128, 128, (bf16_t*)(ws + OFF_WC1K), scr, lane, gw, NGW);
        conv_plain(p.in[24], 2048, 128, 128, (bf16_t*)(ws + OFF_WC1V), scr, lane, gw, NGW);
        conv_plain(p.in[22], 128, 64, 64, (bf16_t*)(ws + OFF_WC2K), scr, lane, gw, NGW);
        conv_plain(p.in[25], 128, 64, 64, (bf16_t*)(ws + OFF_WC2V), scr, lane, gw, NGW);
        for (int row = gw; row < S_; row += NGW) rms_row_to_bf16(p.in[0] + (size_t)row * D_, p.in[2], XN + (size_t)row * D_, lane);
        for (int row = gw; row < MEM_; row += NGW) rms_row_to_bf16(p.in[1] + (size_t)row * D_, p.in[29], (bf16_t*)(ws + OFF_MEMN) + (size_t)row * D_, lane);
        { bf16_t* WL = (bf16_t*)(ws + OFF_WLORA);
          for (int i = gtid; i < LORA_N * LORA_K; i += NT) { const int n = i / LORA_K, k = i % LORA_K; float v = 0.f;
              if (n < 1024) { if (k < 64) v = p.in[11][k * 1024 + n]; }
              else if (n < 2048) { if (k >= 64 && k < 128) v = p.in[13][(k - 64) * 1024 + n - 1024]; }
              else { if (k >= 128 && k < 288) v = p.in[14][(k - 128) * 1024 + n - 2048]; }
              WL[i] = f2bf(v); } }
        { float* RP = (float*)(ws + OFF_ROPE);
          for (int i = gtid; i < S_ * 8; i += NT) { const int pos = i >> 3, f = i & 7;
              const float fr = f == 0 ? 1.000000000e+00f : f == 1 ? 1.939227432e-01f : f == 2 ? 3.760603070e-02f : f == 3 ? 7.292664610e-03f : f == 4 ? 1.414213562e-03f : f == 5 ? 2.742481884e-04f : f == 6 ? 5.318296098e-05f : 1.031338616e-05f;
              const float ang = (float)pos * fr;
              const double rev = (double)ang * 0.15915494309189535; const double fc = rev - rint(rev);
              const float rr = (float)(fc * 6.283185307179586);
              RP[pos * 16 + f] = cosf(rr); RP[pos * 16 + 8 + f] = sinf(rr); } }
    }
    grid.sync();
    ffn_phases(bar, bar_t, lds, ws, XN, ACT, Y, G, bid, wave_s);
    { PHASE_IDX(); norm_phase(p.in[0], Y, 0.5f, p.in[6], p.out, p.in[7], XN, lane, gw, NGW); }
    bar_t += G; gsync(bar, bar_t, wave_s);
    { pg8::StaticOrder so; so.init(S_, IN_PAD, G, bid);
      pg8::Gemm g{XN, (const bf16_t*)(ws + OFF_WIN), S_, IN_PAD, D_};
      pg8::EpiBf16 e{ACT, IN_PAD};
      pg8::gemm_phase(lds, g, so, e, wave_s); }
    bar_t += G; gsync(bar, bar_t, wave_s);
    {
        PHASE_IDX();
        const bf16_t* FE = ACT;
        if (wave < 2) { for (int task = bid * 2 + wave; task < 512; task += G * 2) compress_task(p, ws, task, lane); }
        else {
        const int gtid = (bid * 6 + wave - 2) * 64 + lane, NT = G * 384;
        { float* KN2 = (float*)(ws + OFF_KN2);
          for (int pr = bid * 6 + wave - 2; pr < S_ * 16; pr += G * 6) { const int t = pr >> 4, c = (pr & 15) * 64 + lane;
              const float kx = shiftv(FE, t, C_K + c, p.in[9][C_K + c]) * p.in[15][c]; const float ss = wave_sum(kx * kx);
              if (lane == 0) KN2[pr] = __builtin_amdgcn_rsqf(fmaxf(ss, 1e-24f)); } }
        { bf16_t* XL = (bf16_t*)(ws + OFF_XL);
          for (int i = gtid; i < S_ * LORA_K; i += NT) { const int t = i / LORA_K, c = i % LORA_K; float v = 0.f;
              if (c < 288) { const float s = shiftv(FE, t, C_WD + c, p.in[9][C_WD + c]); v = c < 64 ? tanhf_(s) : (c < 128 ? s : sigmoidf_(s)); }
              XL[i] = f2bf(v); } }
        { const float* RP = (const float*)(ws + OFF_ROPE);
          for (int i = gtid; i < S_ * 4 * 2; i += NT) { const int which = i & 1, g = (i >> 1) & 3, t = i >> 3;
              const bf16_t* srcp = FE + (size_t)t * IN_PAD + (which ? C_KW : C_KS) + g * 64;
              bf16_t* dstp = (bf16_t*)(ws + (which ? OFF_KWR : OFF_KSR)) + ((size_t)g * (S_ / 16) + (t >> 4)) * 1024 + (t & 15) * 32;
              const bf16x8 a = *(const bf16x8*)srcp, b = *(const bf16x8*)(srcp + 8); const float* cs = RP + (size_t)t * 16; float va[8], vb[8];
#pragma unroll
              for (int j = 0; j < 8; ++j) { const float x1 = bf2f((bf16_t)a[j]), x2 = bf2f((bf16_t)b[j]); va[j] = x1 * cs[j] - x2 * cs[8 + j]; vb[j] = x2 * cs[j] + x1 * cs[8 + j]; }
              u32x4 o; o.x = pk2(va[0], va[1]); o.y = pk2(va[2], va[3]); o.z = pk2(va[4], va[5]); o.w = pk2(va[6], va[7]); *(u32x4*)dstp = o;
              o.x = pk2(vb[0], vb[1]); o.y = pk2(vb[2], vb[3]); o.z = pk2(vb[4], vb[5]); o.w = pk2(vb[6], vb[7]); *(u32x4*)(dstp + 8) = o;
#pragma unroll
              for (int j = 2; j < 8; ++j) *(u32x4*)(dstp + (j >> 2) * 512 + (j & 3) * 8) = *(const u32x4*)(srcp + j * 8); } }
        { for (int i = gtid; i < 2 * 256 * (S_ / 8); i += NT) { const int gd = i & 255, which = (i >> 8) & 1, tc = i >> 9;
              const bf16_t* srcp = FE + (size_t)tc * 8 * IN_PAD + (which ? C_VW : C_VS) + gd;
              bf16_t v[8];
#pragma unroll
              for (int j = 0; j < 8; ++j) v[j] = srcp[(size_t)j * IN_PAD];
              u32x4 o; o.x = v[0] | ((unsigned)v[1] << 16); o.y = v[2] | ((unsigned)v[3] << 16); o.z = v[4] | ((unsigned)v[5] << 16); o.w = v[6] | ((unsigned)v[7] << 16);
              bf16_t* dv = (bf16_t*)(ws + (which ? OFF_VWT : OFF_VST)) + (((size_t)(gd >> 6) * (S_ / 32) + (tc >> 2)) * 4 + ((gd & 63) >> 4)) * 512 + (gd & 15) * 32 + (tc & 1) * 16 + ((tc & 3) >> 1) * 4;
              u32x2 lo2; lo2.x = o.x; lo2.y = o.y; u32x2 hi2; hi2.x = o.z; hi2.y = o.w; *(u32x2*)dv = lo2; *(u32x2*)(dv + 8) = hi2; } }
        }
    }
    bar_t += G; gsync(bar, bar_t, wave_s);
    { pg8::StaticOrder so; so.init(S_, LORA_N, G, bid);
      pg8::Gemm g{(const bf16_t*)(ws + OFF_XL), (const bf16_t*)(ws + OFF_WLORA), S_, LORA_N, LORA_K};
      EpiLora e{(bf16_t*)(ws + OFF_LORA), p.in[10], p.in[12]};
      pg8::gemm_phase(lds, g, so, e, wave_s); }
    bar_t += G; gsync(bar, bar_t, wave_s);
    { PHASE_IDX();
    if (bid < 64) { rwkv_scan_block(p, ws, lds, bid, tid); }
    { {
        const int g0 = (int)(__builtin_amdgcn_s_getreg((3 << 11) | 20) & 3u);
        LAS unsigned* idw = (LAS unsigned*)(lds + NI_ID);
        for (int gi = 0; gi < 4; ++gi) { const int g = (g0 + gi) & 3;
          for (;;) { __syncthreads();
            if (tid == 0) *idw = atomicAdd(ctr + g, 1u);
            __syncthreads();
            const unsigned id = __builtin_amdgcn_readfirstlane(*idw);
            if (id >= (unsigned)(S_ / 64)) break;
            nsa_item(ws, lds, (S_ / 64 - 1) - (int)id, g, wave, lane); } } }
    } }
    bar_t += G; gsync(bar, bar_t, wave_s);
    {
        PHASE_IDX();
        const bf16_t* FE = ACT; const bf16_t* LO = (const bf16_t*)(ws + OFF_LORA); const bf16_t* YR = (const bf16_t*)(ws + OFF_YRAW);
        for (int task = gw; task < S_ * 4; task += NGW) { const int t4 = (task >> 4) * 4, h = task & 15, c = h * 64 + lane;
            const float mu_r = p.in[9][C_R + c], mu_k = p.in[9][C_K + c], mu_v = p.in[9][C_V + c], lnw = p.in[18][c], lnb = p.in[19][c], kaw = p.in[16][c], rkw = p.in[17][c];
            float fr[5], fk[5], fv[5], yy[4], aa[4], gg[4];
#pragma unroll
            for (int i = 0; i < 5; ++i) { const int t = t4 - 1 + i;
                if (t >= 0) { fr[i] = bf2f(FE[(size_t)t * IN_PAD + C_R + c]); fk[i] = bf2f(FE[(size_t)t * IN_PAD + C_K + c]); fv[i] = bf2f(FE[(size_t)t * IN_PAD + C_V + c]); }
                else { fr[i] = 0.f; fk[i] = 0.f; fv[i] = 0.f; } }
#pragma unroll
            for (int i = 0; i < 4; ++i) { const int t = t4 + i; yy[i] = bf2f(YR[(size_t)t * 1024 + c]); aa[i] = bf2f(LO[(size_t)t * LORA_N + 1024 + c]); gg[i] = bf2f(LO[(size_t)t * LORA_N + 2048 + c]); }
#pragma unroll
            for (int i = 0; i < 4; ++i) {
                const float y = yy[i]; const float mean = wave_sum(y) * (1.f / 64.f); const float d = y - mean; const float var = wave_sum(d * d) * (1.f / 64.f);
                const float yn = d * rsqrtf(var + 64e-5f) * lnw + lnb;
                const float r = fr[i + 1] + mu_r * (fr[i] - fr[i + 1]), k = fk[i + 1] + mu_k * (fk[i] - fk[i + 1]), v = fv[i + 1] + mu_v * (fv[i] - fv[i + 1]);
                const float kp = k * (1.f + (aa[i] - 1.f) * kaw);
                const float bonus = wave_sum(r * kp * rkw) * v;
                XN[(size_t)(t4 + i) * D_ + c] = f2bf((yn + bonus) * gg[i]); } }
    }
    bar_t += G; gsync(bar, bar_t, wave_s);
    { pg8::StaticOrder so; so.init(S_, D_, G, bid);
      pg8::Gemm g{XN, (const bf16_t*)(ws + OFF_WOUT), S_, D_, D_};
      pg8::EpiBf16 e{Y, D_};
      pg8::gemm_phase(lds, g, so, e, wave_s); }
    bar_t += G; gsync(bar, bar_t, wave_s);
    { PHASE_IDX();
    norm_phase(p.out, Y, 1.0f, p.in[27], p.out, p.in[28], XN, lane, gw, NGW);
    conv_gateup(p.in[35], p.in[36], (bf16_t*)(ws + OFF_WGU), scr, lane, gw, NGW);
    conv_plain(p.in[37], FF_, D_, D_, (bf16_t*)(ws + OFF_WD), scr, lane, gw, NGW); }
    bar_t += G; gsync(bar, bar_t, wave_s);
    { pg8::StaticOrder so; so.init(S_, 512, G, bid);
      pg8::Gemm g{XN, (const bf16_t*)(ws + OFF_WMQ), S_, 512, D_};
      pg8::EpiBf16 e{(bf16_t*)(ws + OFF_QM), 512};
      pg8::gemm_phase(lds, g, so, e, wave_s); }
    if (bid >= 128) {
        PHASE_IDX();
        const int kw = (bid - 128) * 8 + wave, KNW = (G - 128) * 8;
        for (int task = kw; task < 1024; task += KNW) { const int mt = task >> 6, nt = task & 63; const int col = lane & 15, quad = lane >> 4;
            const f32x4 c = wave_tile_gemm((const bf16_t*)(ws + OFF_MEMN) + (size_t)mt * 16 * D_, D_, (const bf16_t*)(ws + OFF_WMKV) + (size_t)nt * 16 * D_, D_, D_, lane);
            const int cc = nt * 16 + col, key = mt * 16 + quad * 4;
            if (cc < 512) { bf16_t* K = (bf16_t*)(ws + OFF_KM);
#pragma unroll
                for (int r = 0; r < 4; ++r) K[(size_t)(key + r) * 512 + cc] = f2bf(c[r]); }
            else { bf16_t* V = (bf16_t*)(ws + OFF_VMT) + (size_t)(cc - 512) * 256 + key; u32x2 v; v.x = pk2(c[0], c[1]); v.y = pk2(c[2], c[3]); *(u32x2*)V = v; } }
    }
    bar_t += G; gsync(bar, bar_t, wave_s);
    { PHASE_IDX(); for (int task = gw; task < (S_ / 16) * 4; task += NGW) mem_attn_task(ws, task, lane); }
    bar_t += G; gsync(bar, bar_t, wave_s);
    { pg8::StaticOrder so; so.init(S_, D_, G, bid);
      pg8::Gemm g{(const bf16_t*)(ws + OFF_OM), (const bf16_t*)(ws + OFF_WMO), S_, D_, 512};
      pg8::EpiBf16 e{Y, D_};
      pg8::gemm_phase(lds, g, so, e, wave_s); }
    bar_t += G; gsync(bar, bar_t, wave_s);
    { PHASE_IDX(); norm_phase(p.out, Y, 1.0f, p.in[33], p.out, p.in[34], XN, lane, gw, NGW); }
    bar_t += G; gsync(bar, bar_t, wave_s);
    ffn_phases(bar, bar_t, lds, ws, XN, ACT, Y, G, bid, wave_s);
    { PHASE_IDX(); norm_phase(p.out, Y, 0.5f, p.in[38], p.out, nullptr, XN, lane, gw, NGW); }
}

extern "C" void kernel_launch(void* const* d_in, const int* in_sizes, int n_in, void* d_out, int out_size, void* d_ws, size_t ws_size, hipStream_t stream) {
    constexpr size_t kDynLds = 131072;
    static int grid_blocks = 0;
    if (!grid_blocks) {
        if (n_in != 39 || out_size != S_ * D_ || ws_size < WS_END) { fprintf(stderr, "kernel_launch: unexpected shapes n_in %d out %d ws %zu (need %zu)\n", n_in, out_size, ws_size, (size_t)WS_END); grid_blocks = -1; return; }
        int dev = 0, cus = 0, per_cu = 0;
        hipGetDevice(&dev);
        hipDeviceGetAttribute(&cus, hipDeviceAttributeMultiprocessorCount, dev);
        hipFuncSetAttribute((const void*)hymba_fwd, hipFuncAttributeMaxDynamicSharedMemorySize, (int)kDynLds);
        hipOccupancyMaxActiveBlocksPerMultiprocessor(&per_cu, (const void*)hymba_fwd, 512, kDynLds);
        if (per_cu < 1) per_cu = 1;
        grid_blocks = cus * per_cu;
        if (grid_blocks > 256) grid_blocks = 256;
    }
    if (grid_blocks < 0) return;
    Params p{};
    for (int i = 0; i < 39; ++i) p.in[i] = (const float*)d_in[i];
    p.out = (float*)d_out; p.ws = (unsigned char*)d_ws;
    if (hipMemsetAsync((unsigned char*)d_ws + OFF_CTR, 0, 1024, stream) != hipSuccess) { fprintf(stderr, "memset failed\n"); return; }
    void* args[] = {&p};
    hipError_t e = hipLaunchCooperativeKernel((const void*)hymba_fwd, dim3(grid_blocks), dim3(512), args, kDynLds, stream);
    if (e != hipSuccess) fprintf(stderr, "cooperative launch failed: %s (grid %d)\n", hipGetErrorString(e), grid_blocks);
}
```

```cpp
#include <hip/hip_runtime.h>
#include <hip/hip_cooperative_groups.h>
#include <cstdio>
namespace cg = cooperative_groups;


#define LAS __attribute__((address_space(3)))
typedef unsigned short bf16_t;
typedef short bf16x8 __attribute__((ext_vector_type(8)));
typedef float f32x4 __attribute__((ext_vector_type(4)));
typedef float f32x2 __attribute__((ext_vector_type(2)));
typedef unsigned u32x4 __attribute__((ext_vector_type(4)));
typedef unsigned u32x2 __attribute__((ext_vector_type(2)));

constexpr int S_ = 16384, D_ = 2048, FF_ = 5504, MEM_ = 256;
constexpr int RW_COLS = 3360, NSA_COLS = 2608, IN_COLS = 5968, IN_PAD = 6144;
constexpr int LORA_K = 384, LORA_N = 3072;
constexpr float EPS_ = 1e-6f;

constexpr size_t SZ_WGU = (size_t)2 * FF_ * D_ * 2, SZ_WD = (size_t)D_ * FF_ * 2;
constexpr size_t OFF_WGU = 0;
constexpr size_t OFF_WD = OFF_WGU + SZ_WGU;
constexpr size_t OFF_WIN = OFF_WD + SZ_WD;
constexpr size_t OFF_WOUT = OFF_WIN + (size_t)IN_PAD * D_ * 2;
constexpr size_t OFF_WMQ = OFF_WOUT + (size_t)D_ * D_ * 2;
constexpr size_t OFF_WMO = OFF_WMQ + (size_t)512 * D_ * 2;
constexpr size_t OFF_WMKV = OFF_WMO + (size_t)D_ * 512 * 2;
constexpr size_t OFF_WLORA = OFF_WMKV + (size_t)1024 * D_ * 2;
constexpr size_t OFF_WC1K = OFF_WLORA + (size_t)LORA_N * LORA_K * 2;
constexpr size_t OFF_WC1V = OFF_WC1K + (size_t)128 * 2048 * 2;
constexpr size_t OFF_WC2K = OFF_WC1V + (size_t)128 * 2048 * 2;
constexpr size_t OFF_WC2V = OFF_WC2K + (size_t)64 * 128 * 2;
constexpr size_t OFF_MEMN = OFF_WC2V + (size_t)64 * 128 * 2;
constexpr size_t OFF_KM = OFF_MEMN + (size_t)MEM_ * D_ * 2;
constexpr size_t OFF_VMT = OFF_KM + (size_t)MEM_ * 512 * 2;
constexpr size_t OFF_KCMP = OFF_VMT + (size_t)MEM_ * 512 * 2;
constexpr size_t OFF_VCMPT = OFF_KCMP + (size_t)4 * 1024 * 64 * 2;
constexpr size_t OFF_ROPE = OFF_VCMPT + (size_t)4 * 1024 * 64 * 2;
constexpr size_t OFF_CTR = OFF_ROPE + (size_t)S_ * 16 * 4;
constexpr size_t OFF_XN = ((OFF_CTR + 4096 + 1048575) / 1048576) * 1048576;
constexpr size_t OFF_ACT = OFF_XN + (size_t)S_ * D_ * 2;
constexpr size_t OFF_Y = OFF_ACT + (size_t)S_ * IN_PAD * 2;
constexpr size_t WS_END = OFF_Y + (size_t)S_ * D_ * 4;
constexpr size_t OFF_KSR = 0;
constexpr size_t OFF_KWR = OFF_KSR + (size_t)S_ * 256 * 2;
constexpr size_t OFF_VST = OFF_KWR + (size_t)S_ * 256 * 2;
constexpr size_t OFF_VWT = OFF_VST + (size_t)S_ * 256 * 2;
constexpr size_t OFF_XL = OFF_VWT + (size_t)S_ * 256 * 2;
constexpr size_t OFF_KN2 = OFF_XL + (size_t)S_ * LORA_K * 2;
constexpr size_t OFF_MIXEND = OFF_KN2 + (size_t)S_ * 16 * 4;
static_assert(OFF_MIXEND <= OFF_WIN, "mix temporaries overflow the FFN weight region");
constexpr size_t OFF_LORA = OFF_Y;
constexpr size_t OFF_YRAW = OFF_Y + (size_t)S_ * LORA_N * 2;
constexpr size_t OFF_QM = OFF_ACT;
constexpr size_t OFF_OM = OFF_ACT + (size_t)S_ * 512 * 2;

struct Params {
    const float* in[39];
    float* out;
    unsigned char* ws;
};

__device__ __forceinline__ float bf2f(bf16_t b) { return __uint_as_float(((unsigned)b) << 16); }
__device__ __forceinline__ unsigned pk2(float lo, float hi) { unsigned r; asm("v_cvt_pk_bf16_f32 %0, %1, %2" : "=v"(r) : "v"(lo), "v"(hi)); return r; }
__device__ __forceinline__ bf16_t f2bf(float f) { return (bf16_t)(pk2(f, 0.f) & 0xffffu); }
template <int CTRL> __device__ __forceinline__ float dppf(float x) { return __int_as_float(__builtin_amdgcn_update_dpp(0, __float_as_int(x), CTRL, 0xf, 0xf, false)); }
__device__ __forceinline__ float rowsum16(float x) { x += dppf<0x128>(x); x += dppf<0x124>(x); x += dppf<0x122>(x); x += dppf<0x121>(x); return x; }
__device__ __forceinline__ float rowmax16(float x) { x = fmaxf(x, dppf<0x128>(x)); x = fmaxf(x, dppf<0x124>(x)); x = fmaxf(x, dppf<0x122>(x)); x = fmaxf(x, dppf<0x121>(x)); return x; }
__device__ __forceinline__ float quad_allmax(float x) {
    auto r = __builtin_amdgcn_permlane32_swap(__float_as_uint(x), __float_as_uint(x), false, false); x = fmaxf(__uint_as_float(r[0]), __uint_as_float(r[1]));
    auto q = __builtin_amdgcn_permlane16_swap(__float_as_uint(x), __float_as_uint(x), false, false); return fmaxf(__uint_as_float(q[0]), __uint_as_float(q[1]));
}
__device__ __forceinline__ float quad_allsum(float x) {
    auto r = __builtin_amdgcn_permlane32_swap(__float_as_uint(x), __float_as_uint(x), false, false); x = __uint_as_float(r[0]) + __uint_as_float(r[1]);
    auto q = __builtin_amdgcn_permlane16_swap(__float_as_uint(x), __float_as_uint(x), false, false); return __uint_as_float(q[0]) + __uint_as_float(q[1]);
}
__device__ __forceinline__ float wave_sum(float v) { return quad_allsum(rowsum16(v)); }
__device__ __forceinline__ float wave_max(float v) { return quad_allmax(rowmax16(v)); }
__device__ __forceinline__ float sigmoidf_(float x) { return __builtin_amdgcn_rcpf(1.f + __expf(-x)); }
#define LDS_WAIT() asm volatile("s_waitcnt lgkmcnt(0)" ::: "memory")

namespace pg8 {
constexpr int BM = 256, BK = 64, HALF = 128, HTB = HALF * BK * 2, STAGE_BYTES = 8 * HTB, NXCD = 8, WGM = 4;
__host__ __device__ __forceinline__ int lds_byte(int r, int c) { const int st = (r >> 4) * 2 + (c >> 5), rr = r & 15, cc = c & 31, ob = rr * 64 + cc * 2; return st * 1024 + (ob ^ (((ob >> 9) & 1) << 5)); }
__host__ __device__ __forceinline__ void stage_rc(int b, int& R, int& C) { const int st = b / 1024, sb = b % 1024, swz = sb ^ (((sb >> 9) & 1) << 5); R = (st >> 1) * 16 + swz / 64; C = (st & 1) * 32 + (swz % 64) / 2; }
__host__ __device__ __forceinline__ int perm32(int rho) { const int n = rho >> 4, i = rho & 15; return 8 * (i >> 2) + 4 * n + (i & 3); }
struct Unit { int pm, pn; };
struct Gemm { const bf16_t* A; const bf16_t* Bt; int M, N, K; };
struct StaticOrder {
    int nM, nN, nwg, G, c;
    __device__ void init(int M, int N, int G_, int c_) { nM = M / BM; nN = N / BM; nwg = nM * nN; G = G_; c = c_; }
    __device__ bool next(int i, Unit& u) const {
        const long L = (long)i * G + c; if (L >= nwg) return false;
        int wgid = (int)L; { const int q = nwg / NXCD, r = nwg % NXCD, xcd = wgid % NXCD, off = wgid / NXCD; wgid = (xcd < r ? xcd * (q + 1) : r * (q + 1) + (xcd - r) * q) + off; }
        const int nig = WGM * nN, gid = wgid / nig, fm = gid * WGM, gsz = (nM - fm) < WGM ? (nM - fm) : WGM;
        u.pm = fm + ((wgid % nig) % gsz); u.pn = (wgid % nig) / gsz; return true;
    }
};

template <class Epi>
__device__ __forceinline__ void gemm_phase(LAS unsigned char* lds, const Gemm g, const StaticOrder& S, const Epi& E, const int wave_s) {
    int lane; asm volatile("v_mbcnt_lo_u32_b32 %0, -1, 0\n\tv_mbcnt_hi_u32_b32 %0, -1, %0" : "=v"(lane));
    const int wid = wave_s; const int tid = wid * 64 + lane; const int wr = wid >> 2, wc = wid & 3, fr = lane & 15, fq = lane >> 4;
    const int K = g.K, nt = K / BK;
    unsigned voffA[2], voffB[2];
#pragma unroll
    for (int i = 0; i < 2; ++i) { int R, C; stage_rc(tid * 16 + i * 8192, R, C); const int Rb = Epi::PERM ? ((R & ~31) + perm32(R & 31)) : R;
        voffA[i] = (unsigned)(R * K + C) * 2u; voffB[i] = (unsigned)(Rb * K + C) * 2u; }
    const size_t kstep = (size_t)(BK * 2);
    const size_t hstep = (size_t)HALF * K * 2;
    const size_t tstep = 2 * hstep;
    const unsigned ldsw = (unsigned)wid * 1024u;
    const int aoff = lds_byte(wr * 64 + fr, fq * 8), boff = lds_byte(wc * 32 + fr, fq * 8);
#define PG8_SA(b, h) (((b) * 2 + (h)) * HTB)
#define PG8_SB(b, h) ((4 + (b) * 2 + (h)) * HTB)
#define PG8_STAGE(bufoff, gbase, voff) do { _Pragma("unroll") for (int _i = 0; _i < 2; ++_i) \
        __builtin_amdgcn_global_load_lds((const unsigned*)((const char*)(gbase) + (voff)[_i]), (LAS unsigned*)(lds + (bufoff) + ldsw + _i * 8192), 16, 0, 0); } while (0)
#define PG8_LDA(dst, b, h) do { _Pragma("unroll") for (int m = 0; m < 4; ++m) _Pragma("unroll") for (int k = 0; k < 2; ++k) dst[m][k] = *(const LAS bf16x8*)(lds + PG8_SA(b, h) + aoff + m * 2048 + k * 1024); } while (0)
#define PG8_LDB(dst, b, h) do { _Pragma("unroll") for (int n = 0; n < 2; ++n) _Pragma("unroll") for (int k = 0; k < 2; ++k) dst[n][k] = *(const LAS bf16x8*)(lds + PG8_SB(b, h) + boff + n * 2048 + k * 1024); } while (0)
#define PG8_MMA(ai, bj, At, Bt) do { __builtin_amdgcn_s_setprio(1); _Pragma("unroll") for (int m = 0; m < 4; ++m) _Pragma("unroll") for (int n = 0; n < 2; ++n) _Pragma("unroll") for (int k = 0; k < 2; ++k) \
        acc[ai][bj][m][n] = __builtin_amdgcn_mfma_f32_16x16x32_bf16(Bt[n][k], At[m][k], acc[ai][bj][m][n], 0, 0, 0); __builtin_amdgcn_s_setprio(0); } while (0)
#define PG8_WAIT_V(n) asm volatile("s_waitcnt vmcnt(" #n ")" ::: "memory")
#define PG8_WAIT_L(n) asm volatile("s_waitcnt lgkmcnt(" #n ")" ::: "memory")
#define PG8_BAR __builtin_amdgcn_s_barrier()
#define PG8_SCHED __builtin_amdgcn_sched_barrier(0)
    Unit cur, nxt; int ui = 0;
    if (!S.next(0, cur)) return;
    f32x4 acc[2][2][4][2];
#pragma unroll
    for (int a = 0; a < 2; ++a)
#pragma unroll
        for (int b = 0; b < 2; ++b)
#pragma unroll
            for (int m = 0; m < 4; ++m)
#pragma unroll
                for (int n = 0; n < 2; ++n) acc[a][b][m][n] = (f32x4){0.f, 0.f, 0.f, 0.f};
    bf16x8 At[4][2], B0[2][2], B1[2][2];
    const char* cA = (const char*)g.A + (size_t)cur.pm * tstep; const char* cB = (const char*)g.Bt + (size_t)cur.pn * tstep;
    PG8_STAGE(PG8_SB(0, 0), cB, voffB); PG8_STAGE(PG8_SA(0, 0), cA, voffA); PG8_STAGE(PG8_SB(0, 1), cB + hstep, voffB); PG8_STAGE(PG8_SA(0, 1), cA + hstep, voffA);
    if (wr == 1) PG8_BAR;
    PG8_WAIT_V(4); PG8_BAR;
    PG8_STAGE(PG8_SB(1, 0), cB + kstep, voffB); PG8_STAGE(PG8_SA(1, 0), cA + kstep, voffA); PG8_STAGE(PG8_SB(1, 1), cB + hstep + kstep, voffB);
    PG8_WAIT_V(6); PG8_BAR;
    for (;;) {
        const bool has_next = S.next(ui + 1, nxt);
        const char* nA = has_next ? (const char*)g.A + (size_t)nxt.pm * tstep : cA; const char* nB = has_next ? (const char*)g.Bt + (size_t)nxt.pn * tstep : cB;
        for (int t = 0; t < nt; t += 2) {
            const bool last = (t == nt - 2);
            const char* a1 = cA + (size_t)(t + 1) * kstep;
            const char* a2 = last ? nA : cA + (size_t)(t + 2) * kstep; const char* b2 = last ? nB : cB + (size_t)(t + 2) * kstep;
            const char* a3 = a2 + kstep; const char* b3 = b2 + kstep;
            PG8_LDB(B0, 0, 0); PG8_SCHED; PG8_LDA(At, 0, 0); PG8_STAGE(PG8_SA(1, 1), a1 + hstep, voffA);
            PG8_WAIT_L(8); PG8_BAR; PG8_WAIT_L(0); PG8_MMA(0, 0, At, B0); PG8_BAR; PG8_SCHED;
            PG8_LDB(B1, 0, 1); PG8_STAGE(PG8_SB(0, 0), b2, voffB);
            PG8_BAR; PG8_WAIT_L(0); PG8_MMA(0, 1, At, B1); PG8_BAR;
            PG8_LDA(At, 0, 1); PG8_STAGE(PG8_SA(0, 0), a2, voffA);
            PG8_BAR; PG8_WAIT_L(0); PG8_MMA(1, 0, At, B0); PG8_BAR; PG8_SCHED;
            PG8_STAGE(PG8_SB(0, 1), b2 + hstep, voffB);
            PG8_WAIT_V(6); PG8_BAR; PG8_MMA(1, 1, At, B1); PG8_BAR;
            PG8_LDB(B0, 1, 0); PG8_SCHED; PG8_LDA(At, 1, 0); PG8_STAGE(PG8_SA(0, 1), a2 + hstep, voffA);
            PG8_WAIT_L(8); PG8_BAR; PG8_WAIT_L(0); PG8_MMA(0, 0, At, B0); PG8_BAR; PG8_SCHED;
            PG8_LDB(B1, 1, 1); PG8_STAGE(PG8_SB(1, 0), b3, voffB);
            PG8_BAR; PG8_WAIT_L(0); PG8_MMA(0, 1, At, B1); PG8_BAR;
            PG8_LDA(At, 1, 1); PG8_STAGE(PG8_SA(1, 0), a3, voffA);
            PG8_BAR; PG8_WAIT_L(0); PG8_MMA(1, 0, At, B0); PG8_BAR; PG8_SCHED;
            PG8_STAGE(PG8_SB(1, 1), b3 + hstep, voffB);
            PG8_WAIT_V(6); PG8_BAR; PG8_MMA(1, 1, At, B1); PG8_BAR;
        }
        E(acc, cur, wr, wc, fr, fq);
        if (!has_next) break;
#pragma unroll
        for (int a = 0; a < 2; ++a)
#pragma unroll
            for (int b = 0; b < 2; ++b)
#pragma unroll
                for (int m = 0; m < 4; ++m)
#pragma unroll
                    for (int n = 0; n < 2; ++n) acc[a][b][m][n] = (f32x4){0.f, 0.f, 0.f, 0.f};
        cur = nxt; cA = nA; cB = nB; ++ui;
    }
    PG8_WAIT_V(0);
    if (wr == 0) PG8_BAR;
    PG8_BAR;
#undef PG8_SA
#undef PG8_SB
#undef PG8_STAGE
#undef PG8_LDA
#undef PG8_LDB
#undef PG8_MMA
#undef PG8_WAIT_V
#undef PG8_WAIT_L
#undef PG8_BAR
#undef PG8_SCHED
}

struct EpiF32 {
    static constexpr bool PERM = false;
    float* C; int ldc;
    __device__ __forceinline__ void operator()(const f32x4 (&acc)[2][2][4][2], const Unit& u, int wr, int wc, int fr, int fq) const {
        const int row0 = u.pm * BM + wr * 64 + fr, col0 = u.pn * BM + wc * 32 + 4 * fq;
#pragma unroll
        for (int ai = 0; ai < 2; ++ai)
#pragma unroll
            for (int m = 0; m < 4; ++m) { float* rowp = C + (size_t)(row0 + ai * HALF + m * 16) * ldc + col0;
#pragma unroll
                for (int bj = 0; bj < 2; ++bj)
#pragma unroll
                    for (int n = 0; n < 2; ++n) *(f32x4*)(rowp + bj * HALF + n * 16) = acc[ai][bj][m][n]; }
    }
};
struct EpiBf16 {
    static constexpr bool PERM = true;
    bf16_t* O; int ldc;
    __device__ __forceinline__ void operator()(const f32x4 (&acc)[2][2][4][2], const Unit& u, int wr, int wc, int fr, int fq) const {
        const int row0 = u.pm * BM + wr * 64 + fr, col0 = u.pn * BM + wc * 32 + 8 * fq;
#pragma unroll
        for (int ai = 0; ai < 2; ++ai)
#pragma unroll
            for (int m = 0; m < 4; ++m) { bf16_t* rowp = O + (size_t)(row0 + ai * HALF + m * 16) * ldc + col0;
#pragma unroll
                for (int bj = 0; bj < 2; ++bj) { const f32x4 v0 = acc[ai][bj][m][0], v1 = acc[ai][bj][m][1];
                    u32x4 o; o.x = pk2(v0[0], v0[1]); o.y = pk2(v0[2], v0[3]); o.z = pk2(v1[0], v1[1]); o.w = pk2(v1[2], v1[3]);
                    *(u32x4*)(rowp + bj * HALF) = o; } }
    }
};
struct EpiSwiGLU {
    static constexpr bool PERM = true;
    bf16_t* O; int ldc;
    __device__ __forceinline__ void operator()(const f32x4 (&acc)[2][2][4][2], const Unit& u, int wr, int wc, int fr, int fq) const {
        const int row0 = u.pm * BM + wr * 64 + fr, col0 = u.pn * HALF + wc * 32 + 8 * fq;
#pragma unroll
        for (int ai = 0; ai < 2; ++ai)
#pragma unroll
            for (int m = 0; m < 4; ++m) { bf16_t* rowp = O + (size_t)(row0 + ai * HALF + m * 16) * ldc + col0;
                float v[8];
#pragma unroll
                for (int n = 0; n < 2; ++n)
#pragma unroll
                    for (int i = 0; i < 4; ++i) { const float gt = acc[ai][0][m][n][i], up = acc[ai][1][m][n][i]; v[n * 4 + i] = gt * sigmoidf_(gt) * up; }
                u32x4 o; o.x = pk2(v[0], v[1]); o.y = pk2(v[2], v[3]); o.z = pk2(v[4], v[5]); o.w = pk2(v[6], v[7]);
                *(u32x4*)rowp = o; }
    }
};
}

__device__ __forceinline__ void transpose_item(const float* __restrict__ W, int ldw, int ncols, int c0, int k0, bf16_t* dst, int ldd, LAS float* scr, int lane) {
    float tv[32]; const int cc = c0 + (lane & 31); const float* wp = W + (size_t)(k0 + (lane >> 5)) * ldw + cc;
#pragma unroll
    for (int i = 0; i < 32; ++i) tv[i] = (cc < ncols) ? wp[(size_t)(2 * i) * ldw] : 0.f;
#pragma unroll
    for (int i = 0; i < 32; ++i) scr[(2 * i + (lane >> 5)) * 33 + (lane & 31)] = tv[i];
    LDS_WAIT();
    const int c = lane & 7;
#pragma unroll
    for (int j = 0; j < 4; ++j) { const int n = (lane >> 3) + 8 * j; const LAS float* s = scr + (8 * c) * 33 + n;
        u32x4 o; o.x = pk2(s[0 * 33], s[1 * 33]); o.y = pk2(s[2 * 33], s[3 * 33]); o.z = pk2(s[4 * 33], s[5 * 33]); o.w = pk2(s[6 * 33], s[7 * 33]);
        *(u32x4*)(dst + (size_t)n * ldd + k0 + 8 * c) = o; }
    LDS_WAIT();
}
__device__ __forceinline__ void conv_plain(const float* W, int K, int N, int Npad, bf16_t* dst, LAS float* scr, int lane, int gw, int NGW) {
    const int nblk = Npad / 32, items = (K / 64) * nblk;
    for (int it = gw; it < items; it += NGW) { const int kb = it / nblk, nb = it % nblk;
        transpose_item(W, N, N, nb * 32, kb * 64, dst + (size_t)nb * 32 * K, K, scr, lane); }
}
__device__ __forceinline__ void conv_gateup(const float* Wg, const float* Wu, bf16_t* dst, LAS float* scr, int lane, int gw, int NGW) {
    const int nblk = (2 * FF_) / 32, items = (D_ / 64) * nblk;
    for (int it = gw; it < items; it += NGW) { const int kb = it / nblk, nb = it % nblk; const int n0 = nb * 32, tile = n0 >> 8, w = n0 & 255;
        const float* W = (w < 128) ? Wg : Wu; const int c0 = tile * 128 + (w & 127);
        transpose_item(W, FF_, FF_, c0, kb * 64, dst + (size_t)n0 * D_, D_, scr, lane); }
}
__device__ __forceinline__ void rms_row_to_bf16(const float* xrow, const float* g, bf16_t* orow, int lane) {
    const f32x4* xr = (const f32x4*)xrow + lane; const f32x4* gr = (const f32x4*)g + lane;
    f32x4 v[8]; float s = 0.f;
#pragma unroll
    for (int j = 0; j < 8; ++j) { v[j] = xr[64 * j]; s += (v[j].x * v[j].x + v[j].y * v[j].y) + (v[j].z * v[j].z + v[j].w * v[j].w); }
    const float rs = rsqrtf(wave_sum(s) * (1.f / D_) + EPS_);
    u32x2* o8 = (u32x2*)orow + lane;
#pragma unroll
    for (int j = 0; j < 8; ++j) { const f32x4 gg = gr[64 * j]; u32x2 o; o.x = pk2(v[j].x * rs * gg.x, v[j].y * rs * gg.y); o.y = pk2(v[j].z * rs * gg.z, v[j].w * rs * gg.w); o8[64 * j] = o; }
}
__device__ __forceinline__ void norm_phase(const float* hin, const bf16_t* Y, float coef, const float* g_post, float* hout, const float* g_pre, bf16_t* xn, int lane, int gw, int NGW) {
    for (int row = gw; row < S_; row += NGW) {
        const u32x2* yr = (const u32x2*)(Y + (size_t)row * D_) + lane; const f32x4* hr = (const f32x4*)(hin + (size_t)row * D_) + lane;
        const f32x4* gp = (const f32x4*)g_post + lane;
        f32x4 v[8]; float s = 0.f;
#pragma unroll
        for (int j = 0; j < 8; ++j) { const u32x2 w = yr[64 * j]; v[j].x = __uint_as_float(w.x << 16); v[j].y = __uint_as_float(w.x & 0xffff0000u); v[j].z = __uint_as_float(w.y << 16); v[j].w = __uint_as_float(w.y & 0xffff0000u);
            s += (v[j].x * v[j].x + v[j].y * v[j].y) + (v[j].z * v[j].z + v[j].w * v[j].w); }
        const float rs = rsqrtf(wave_sum(s) * (1.f / D_) + EPS_) * coef;
        f32x4* ho = (f32x4*)(hout + (size_t)row * D_) + lane;
        float s2 = 0.f;
#pragma unroll
        for (int j = 0; j < 8; ++j) { const f32x4 gg = gp[64 * j]; const f32x4 h = hr[64 * j];
            v[j].x = h.x + v[j].x * rs * gg.x; v[j].y = h.y + v[j].y * rs * gg.y; v[j].z = h.z + v[j].z * rs * gg.z; v[j].w = h.w + v[j].w * rs * gg.w;
            ho[64 * j] = v[j]; s2 += (v[j].x * v[j].x + v[j].y * v[j].y) + (v[j].z * v[j].z + v[j].w * v[j].w); }
        if (g_pre) {
            const float rs2 = rsqrtf(wave_sum(s2) * (1.f / D_) + EPS_);
            const f32x4* gq = (const f32x4*)g_pre + lane; u32x2* o8 = (u32x2*)(xn + (size_t)row * D_) + lane;
#pragma unroll
            for (int j = 0; j < 8; ++j) { const f32x4 gg = gq[64 * j]; u32x2 o; o.x = pk2(v[j].x * rs2 * gg.x, v[j].y * rs2 * gg.y); o.y = pk2(v[j].z * rs2 * gg.z, v[j].w * rs2 * gg.w); o8[64 * j] = o; }
        }
    }
}

__device__ __forceinline__ f32x4 wave_tile_gemm(const bf16_t* A, int lda, const bf16_t* Bt, int ldb, int K, int lane) {
    const bf16_t* ap = A + (size_t)(lane & 15) * lda + (lane >> 4) * 8; const bf16_t* bp = Bt + (size_t)(lane & 15) * ldb + (lane >> 4) * 8;
    f32x4 acc = {0.f, 0.f, 0.f, 0.f};
#pragma unroll 4
    for (int k = 0; k < K; k += 32) { const bf16x8 a = *(const bf16x8*)(ap + k), b = *(const bf16x8*)(bp + k); acc = __builtin_amdgcn_mfma_f32_16x16x32_bf16(a, b, acc, 0, 0, 0); }
    return acc;
}


__device__ __forceinline__ float tanhf_(float x) { const float e = __expf(2.f * x); return 1.f - 2.f * __builtin_amdgcn_rcpf(e + 1.f); }
__device__ __forceinline__ float gelu_tanh(float x) { return 0.5f * x * (1.f + tanhf_(0.7978845608f * (x + 0.044715f * x * x * x))); }
__device__ __forceinline__ bf16x8 pack8(const f32x4 a, const f32x4 b) { u32x4 o; o.x = pk2(a[0], a[1]); o.y = pk2(a[2], a[3]); o.z = pk2(b[0], b[1]); o.w = pk2(b[2], b[3]); return __builtin_bit_cast(bf16x8, o); }
__device__ __forceinline__ bf16x8 ld2x4(const bf16_t* p0, const bf16_t* p1) { const u32x2 a = *(const u32x2*)p0, b = *(const u32x2*)p1; u32x4 o; o.x = a.x; o.y = a.y; o.z = b.x; o.w = b.y; return __builtin_bit_cast(bf16x8, o); }
__device__ __forceinline__ float shiftv(const bf16_t* F, int t, int col, float mu) { const float f = bf2f(F[(size_t)t * IN_PAD + col]); const float fp = t > 0 ? bf2f(F[(size_t)(t - 1) * IN_PAD + col]) : 0.f; return f + mu * (fp - f); }

constexpr int C_R = 0, C_K = 1024, C_V = 2048, C_WD = 3072, C_Q = 3360, C_KC = 4384, C_VC = 4640, C_KS = 4896, C_VS = 5152, C_KW = 5408, C_VW = 5664, C_GL = 5920;

struct EpiLora {
    static constexpr bool PERM = true;
    bf16_t* O; const float* w0; const float* a0;
    __device__ __forceinline__ void operator()(const f32x4 (&acc)[2][2][4][2], const pg8::Unit& u, int wr, int wc, int fr, int fq) const {
        { int ln; asm volatile("v_mbcnt_lo_u32_b32 %0, -1, 0\n\tv_mbcnt_hi_u32_b32 %0, -1, %0" : "=v"(ln)); fr = ln & 15; fq = ln >> 4; }
        const int row0 = u.pm * 256 + wr * 64 + fr, col0 = u.pn * 256 + wc * 32 + 8 * fq; const int type = u.pn >> 2;
#pragma unroll
        for (int ai = 0; ai < 2; ++ai)
#pragma unroll
            for (int m = 0; m < 4; ++m) { bf16_t* rowp = O + (size_t)(row0 + ai * 128 + m * 16) * LORA_N + col0;
#pragma unroll
                for (int bj = 0; bj < 2; ++bj) { float v[8];
#pragma unroll
                    for (int n = 0; n < 2; ++n)
#pragma unroll
                        for (int i = 0; i < 4; ++i) { float x = acc[ai][bj][m][n][i]; const int c = (col0 + bj * 128 + n * 4 + i) & 1023;
                            if (type == 0) x = 0.60653066f * sigmoidf_(x + w0[c]); else if (type == 1) x = sigmoidf_(x + a0[c]);
                            v[n * 4 + i] = x; }
                    u32x4 o; o.x = pk2(v[0], v[1]); o.y = pk2(v[2], v[3]); o.z = pk2(v[4], v[5]); o.w = pk2(v[6], v[7]);
                    *(u32x4*)(rowp + bj * 128) = o; } }
    }
};

__device__ __forceinline__ void compress_task(const Params& p, unsigned char* ws, int task, int lane) {
    const int which = task >> 8, g = (task >> 6) & 3, n0 = (task & 63) * 16;
    const bf16_t* FE = (const bf16_t*)(ws + OFF_ACT);
    const bf16_t* W1T = (const bf16_t*)(ws + (which ? OFF_WC1V : OFF_WC1K));
    const bf16_t* W2T = (const bf16_t*)(ws + (which ? OFF_WC2V : OFF_WC2K));
    const float* pe = which ? p.in[23] : p.in[20];
    const int cb = (which ? C_VC : C_KC) + g * 64;
    const int col = lane & 15, quad = lane >> 4;
    int nn = n0 + col; if (nn > 1022) nn = 1022;
    f32x4 acc[8];
#pragma unroll
    for (int i = 0; i < 8; ++i) acc[i] = (f32x4){0.f, 0.f, 0.f, 0.f};
    for (int kt = 0; kt < 64; ++kt) {
        const int pp = kt >> 1, d = (kt & 1) * 32 + quad * 8;
        const bf16x8 xf = *(const bf16x8*)(FE + (size_t)(16 * nn + pp) * IN_PAD + cb + d);
        const f32x4 pa = *(const f32x4*)(pe + pp * 64 + d), pb = *(const f32x4*)(pe + pp * 64 + d + 4);
        const bf16x8 pf = pack8(pa, pb);
#pragma unroll
        for (int ct = 0; ct < 8; ++ct) { const bf16x8 wf = *(const bf16x8*)(W1T + (size_t)(ct * 16 + col) * 2048 + kt * 32 + quad * 8);
            acc[ct] = __builtin_amdgcn_mfma_f32_16x16x32_bf16(wf, xf, acc[ct], 0, 0, 0);
            acc[ct] = __builtin_amdgcn_mfma_f32_16x16x32_bf16(wf, pf, acc[ct], 0, 0, 0); }
    }
#pragma unroll
    for (int ct = 0; ct < 8; ++ct)
#pragma unroll
        for (int r = 0; r < 4; ++r) acc[ct][r] = gelu_tanh(acc[ct][r]);
    f32x4 o[4];
#pragma unroll
    for (int et = 0; et < 4; ++et) { o[et] = (f32x4){0.f, 0.f, 0.f, 0.f};
#pragma unroll
        for (int i = 0; i < 4; ++i) { const bf16x8 hf = pack8(acc[2 * i], acc[2 * i + 1]);
            const bf16_t* wr_ = W2T + (size_t)(et * 16 + col) * 128 + 32 * i + quad * 4;
            const bf16x8 wf = ld2x4(wr_, wr_ + 16);
            o[et] = __builtin_amdgcn_mfma_f32_16x16x32_bf16(wf, hf, o[et], 0, 0, 0); } }
    const int n = n0 + col;
    if (which == 0) { bf16_t* K = (bf16_t*)(ws + OFF_KCMP) + ((size_t)g * 64 + (n >> 4)) * 1024 + (n & 15) * 32;
#pragma unroll
        for (int et = 0; et < 4; ++et) { u32x2 v; v.x = pk2(o[et][0], o[et][1]); v.y = pk2(o[et][2], o[et][3]); *(u32x2*)(K + (et >> 1) * 512 + (et & 1) * 16 + quad * 4) = v; }
    } else { bf16_t* V = (bf16_t*)(ws + OFF_VCMPT) + ((size_t)g * 32 + (n >> 5)) * 2048 + ((n & 15) >> 2) * 8 + ((n >> 4) & 1) * 4 + (n & 3);
#pragma unroll
        for (int et = 0; et < 4; ++et)
#pragma unroll
            for (int r = 0; r < 4; ++r) V[et * 512 + (quad * 4 + r) * 32] = f2bf(o[et][r]);
    }
}

constexpr int SCAN_T = 32, SCAN_BUF_F = 5 * SCAN_T * 64 + SCAN_T * 16;
struct ScanRaw { float rr[9], kr[9], vr[9], uu[8], aa[8], nrm[8]; };
__device__ __forceinline__ void scan_fetch(ScanRaw& x, unsigned char* ws, int c, int head, int rbase, int lw, int lane) {
    const bf16_t* FE = (const bf16_t*)(ws + OFF_ACT); const bf16_t* LO = (const bf16_t*)(ws + OFF_LORA);
    const int cr = head * 64 + lane, vcol = C_V + head * 64 + rbase + (lane & 15), ta = c * SCAN_T + lw * 8;
#pragma unroll
    for (int i = 0; i < 9; ++i) { const int t = ta - 1 + i;
        if (t >= 0) { x.rr[i] = bf2f(FE[(size_t)t * IN_PAD + C_R + cr]); x.kr[i] = bf2f(FE[(size_t)t * IN_PAD + C_K + cr]); x.vr[i] = bf2f(FE[(size_t)t * IN_PAD + vcol]); }
        else { x.rr[i] = 0.f; x.kr[i] = 0.f; x.vr[i] = 0.f; } }
#pragma unroll
    for (int i = 0; i < 8; ++i) { const int t = ta + i; x.uu[i] = bf2f(LO[(size_t)t * LORA_N + cr]); x.aa[i] = bf2f(LO[(size_t)t * LORA_N + 1024 + cr]); x.nrm[i] = ((const float*)(ws + OFF_KN2))[t * 16 + head]; }
}
__device__ __forceinline__ void scan_emit(const ScanRaw& x, LAS float* buf, float mu_r, float mu_k, float mu_v, float kkw, float kaw, int lw, int lane) {
#pragma unroll
    for (int i = 0; i < 8; ++i) { const int tt = lw * 8 + i;
        const float r = x.rr[i + 1] + mu_r * (x.rr[i] - x.rr[i + 1]), k = x.kr[i + 1] + mu_k * (x.kr[i] - x.kr[i + 1]), v = x.vr[i + 1] + mu_v * (x.vr[i] - x.vr[i + 1]);
        const float a = x.aa[i], w = __expf(-x.uu[i]);
        const float kkn = k * kkw * x.nrm[i];
        buf[0 * SCAN_T * 64 + tt * 64 + lane] = w;
        buf[1 * SCAN_T * 64 + tt * 64 + lane] = -kkn;
        buf[2 * SCAN_T * 64 + tt * 64 + lane] = kkn * a;
        buf[3 * SCAN_T * 64 + tt * 64 + lane] = k * (1.f + (a - 1.f) * kaw);
        buf[4 * SCAN_T * 64 + tt * 64 + lane] = r;
        if (lane < 16) buf[5 * SCAN_T * 64 + tt * 16 + lane] = v; }
}
__device__ __forceinline__ void scan_step(float& s0, float& s1, float& s2, float& s3, const f32x4 NK, const f32x4 W, const f32x4 B, const f32x4 R,
                                          float t0, float t1, float t2, float t3, float& yp, float& yc) {
    float sa, tmp;
    asm volatile(
        "v_mul_f32 %[sa], %[s0], %[n0]\n\t"
        "v_mul_f32 %[tmp], %[s2], %[n2]\n\t"
        "v_fmac_f32 %[sa], %[s1], %[n1]\n\t"
        "v_fmac_f32 %[tmp], %[s3], %[n3]\n\t"
        "v_add_f32 %[sa], %[sa], %[tmp]\n\t"
        "s_nop 1\n\t"
        "v_add_f32_dpp %[sa], %[sa], %[sa] row_ror:8 row_mask:0xf bank_mask:0xf\n\t"
        "v_add_f32_dpp %[yp], %[yp], %[yp] row_ror:8 row_mask:0xf bank_mask:0xf\n\t"
        "s_nop 0\n\t"
        "v_add_f32_dpp %[sa], %[sa], %[sa] row_ror:4 row_mask:0xf bank_mask:0xf\n\t"
        "v_add_f32_dpp %[yp], %[yp], %[yp] row_ror:4 row_mask:0xf bank_mask:0xf\n\t"
        "s_nop 0\n\t"
        "v_add_f32_dpp %[sa], %[sa], %[sa] row_ror:2 row_mask:0xf bank_mask:0xf\n\t"
        "v_add_f32_dpp %[yp], %[yp], %[yp] row_ror:2 row_mask:0xf bank_mask:0xf\n\t"
        "s_nop 0\n\t"
        "v_add_f32_dpp %[sa], %[sa], %[sa] row_ror:1 row_mask:0xf bank_mask:0xf\n\t"
        "v_add_f32_dpp %[yp], %[yp], %[yp] row_ror:1 row_mask:0xf bank_mask:0xf\n\t"
        "v_fmac_f32 %[t0], %[sa], %[b0]\n\t"
        "v_fmac_f32 %[t1], %[sa], %[b1]\n\t"
        "v_fmac_f32 %[t2], %[sa], %[b2]\n\t"
        "v_fmac_f32 %[t3], %[sa], %[b3]\n\t"
        "v_fma_f32 %[s0], %[s0], %[w0], %[t0]\n\t"
        "v_fma_f32 %[s1], %[s1], %[w1], %[t1]\n\t"
        "v_fma_f32 %[s2], %[s2], %[w2], %[t2]\n\t"
        "v_fma_f32 %[s3], %[s3], %[w3], %[t3]\n\t"
        "v_mul_f32 %[yc], %[s0], %[r0]\n\t"
        "v_mul_f32 %[tmp], %[s2], %[r2]\n\t"
        "v_fmac_f32 %[yc], %[s1], %[r1]\n\t"
        "v_fmac_f32 %[tmp], %[s3], %[r3]\n\t"
        "v_add_f32 %[yc], %[yc], %[tmp]\n\t"
        : [s0] "+v"(s0), [s1] "+v"(s1), [s2] "+v"(s2), [s3] "+v"(s3), [t0] "+v"(t0), [t1] "+v"(t1), [t2] "+v"(t2), [t3] "+v"(t3),
          [yp] "+v"(yp), [yc] "=&v"(yc), [sa] "=&v"(sa), [tmp] "=&v"(tmp)
        : [n0] "v"(NK.x), [n1] "v"(NK.y), [n2] "v"(NK.z), [n3] "v"(NK.w), [w0] "v"(W.x), [w1] "v"(W.y), [w2] "v"(W.z), [w3] "v"(W.w),
          [b0] "v"(B.x), [b1] "v"(B.y), [b2] "v"(B.z), [b3] "v"(B.w), [r0] "v"(R.x), [r1] "v"(R.y), [r2] "v"(R.z), [r3] "v"(R.w));
}
__device__ __forceinline__ f32x2 scan_dot2(const f32x2 sA, const f32x2 sB, const f32x2 xA, const f32x2 xB) {
    f32x2 t;
    asm volatile("v_pk_mul_f32 %[t], %[sA], %[xA]\n\tv_pk_fma_f32 %[t], %[sB], %[xB], %[t]\n\t" : [t] "=&v"(t) : [sA] "v"(sA), [sB] "v"(sB), [xA] "v"(xA), [xB] "v"(xB));
    return t;
}
__device__ __forceinline__ void scan_reduce2(float& sa, float& yp) {
    asm volatile(
        "s_nop 1\n\t"
        "v_add_f32_dpp %[sa], %[sa], %[sa] row_ror:8 row_mask:0xf bank_mask:0xf\n\t"
        "v_add_f32_dpp %[yp], %[yp], %[yp] row_ror:8 row_mask:0xf bank_mask:0xf\n\t"
        "s_nop 0\n\t"
        "v_add_f32_dpp %[sa], %[sa], %[sa] row_ror:4 row_mask:0xf bank_mask:0xf\n\t"
        "v_add_f32_dpp %[yp], %[yp], %[yp] row_ror:4 row_mask:0xf bank_mask:0xf\n\t"
        "s_nop 0\n\t"
        "v_add_f32_dpp %[sa], %[sa], %[sa] row_ror:2 row_mask:0xf bank_mask:0xf\n\t"
        "v_add_f32_dpp %[yp], %[yp], %[yp] row_ror:2 row_mask:0xf bank_mask:0xf\n\t"
        "s_nop 0\n\t"
        "v_add_f32_dpp %[sa], %[sa], %[sa] row_ror:1 row_mask:0xf bank_mask:0xf\n\t"
        "v_add_f32_dpp %[yp], %[yp], %[yp] row_ror:1 row_mask:0xf bank_mask:0xf\n\t"
        "s_nop 1\n\t"
        : [sa] "+v"(sa), [yp] "+v"(yp));
}
__device__ __forceinline__ void scan_update2(f32x2& sA, f32x2& sB, const f32x2 wA, const f32x2 wB, const f32x2 bA, const f32x2 bB, const f32x2 kA, const f32x2 kB, const f32x2 sa2, const f32x2 vv2) {
    f32x2 uA, uB;
    asm volatile(
        "v_pk_mul_f32 %[uA], %[kA], %[vv2] op_sel_hi:[1,0]\n\t"
        "v_pk_mul_f32 %[uB], %[kB], %[vv2] op_sel_hi:[1,0]\n\t"
        "v_pk_fma_f32 %[uA], %[bA], %[sa2], %[uA] op_sel_hi:[1,0,1]\n\t"
        "v_pk_fma_f32 %[uB], %[bB], %[sa2], %[uB] op_sel_hi:[1,0,1]\n\t"
        "v_pk_fma_f32 %[sA], %[sA], %[wA], %[uA]\n\t"
        "v_pk_fma_f32 %[sB], %[sB], %[wB], %[uB]\n\t"
        : [sA] "+v"(sA), [sB] "+v"(sB), [uA] "=&v"(uA), [uB] "=&v"(uB)
        : [wA] "v"(wA), [wB] "v"(wB), [bA] "v"(bA), [bB] "v"(bB), [kA] "v"(kA), [kB] "v"(kB), [sa2] "v"(sa2), [vv2] "v"(vv2));
}
#define SCAN_BAR() do { asm volatile("s_waitcnt lgkmcnt(0)" ::: "memory"); __builtin_amdgcn_s_barrier(); asm volatile("" ::: "memory"); } while (0)
__device__ __forceinline__ void rwkv_scan_block(const Params& p, unsigned char* ws, LAS unsigned char* lds, int sb, int tid) {
    const int lane = tid & 63, wave = tid >> 6; const int head = sb >> 2, rbase = (sb & 3) * 16;
    LAS float* buf0 = (LAS float*)lds; LAS float* buf1 = buf0 + SCAN_BUF_F;
    bf16_t* YR = (bf16_t*)(ws + OFF_YRAW);
    const int cg_ = lane & 15, rl = (wave & 3) * 4 + (lane >> 4);
    constexpr int NCH = S_ / SCAN_T;
    if (wave >= 4) {
        const int lw = wave - 4; const int cr = head * 64 + lane, vcol = C_V + head * 64 + rbase + (lane & 15);
        const float mu_r = p.in[9][C_R + cr], mu_k = p.in[9][C_K + cr], mu_v = p.in[9][vcol], kkw = p.in[15][cr], kaw = p.in[16][cr];
        ScanRaw x; scan_fetch(x, ws, 0, head, rbase, lw, lane); scan_emit(x, buf0, mu_r, mu_k, mu_v, kkw, kaw, lw, lane); scan_fetch(x, ws, 1, head, rbase, lw, lane);
        SCAN_BAR();
        for (int c = 0; c < NCH; ++c) {
            if (c + 1 < NCH) scan_emit(x, (c & 1) ? buf0 : buf1, mu_r, mu_k, mu_v, kkw, kaw, lw, lane);
            if (c + 2 < NCH) scan_fetch(x, ws, c + 2, head, rbase, lw, lane);
            SCAN_BAR(); }
    } else {
        f32x2 sA = {0.f, 0.f}, sB = {0.f, 0.f};
        SCAN_BAR();
        for (int c = 0; c < NCH; ++c) {
            LAS float* cb = ((c & 1) ? buf1 : buf0) + cg_ * 4; LAS float* vb = ((c & 1) ? buf1 : buf0) + 5 * SCAN_T * 64 + rl;
#pragma unroll
            for (int hh = 0; hh < SCAN_T / 16; ++hh) {
                float ykeep = 0.f, yp = 0.f, yc = 0.f;
                f32x4 W = *(const LAS f32x4*)(cb + 0 * SCAN_T * 64 + hh * 1024), NK = *(const LAS f32x4*)(cb + 1 * SCAN_T * 64 + hh * 1024), B = *(const LAS f32x4*)(cb + 2 * SCAN_T * 64 + hh * 1024),
                      KP = *(const LAS f32x4*)(cb + 3 * SCAN_T * 64 + hh * 1024), R = *(const LAS f32x4*)(cb + 4 * SCAN_T * 64 + hh * 1024); float vv = vb[hh * 256];
#pragma unroll
                for (int ti = 0; ti < 16; ++ti) {
                    const int tn = hh * 16 + (ti < 15 ? ti + 1 : ti);
                    const f32x4 Wn = *(const LAS f32x4*)(cb + 0 * SCAN_T * 64 + tn * 64), NKn = *(const LAS f32x4*)(cb + 1 * SCAN_T * 64 + tn * 64), Bn = *(const LAS f32x4*)(cb + 2 * SCAN_T * 64 + tn * 64),
                                KPn = *(const LAS f32x4*)(cb + 3 * SCAN_T * 64 + tn * 64), Rn = *(const LAS f32x4*)(cb + 4 * SCAN_T * 64 + tn * 64); const float vn = vb[tn * 16];
                    const f32x2 d = scan_dot2(sA, sB, (f32x2){NK.x, NK.y}, (f32x2){NK.z, NK.w});
                    float sa = d.x + d.y; yp = yc;
                    scan_reduce2(sa, yp);
                    f32x2 sa2; sa2.x = sa; sa2.y = sa; f32x2 vv2; vv2.x = vv; vv2.y = vv;
                    scan_update2(sA, sB, (f32x2){W.x, W.y}, (f32x2){W.z, W.w}, (f32x2){B.x, B.y}, (f32x2){B.z, B.w}, (f32x2){KP.x, KP.y}, (f32x2){KP.z, KP.w}, sa2, vv2);
                    const f32x2 e = scan_dot2(sA, sB, (f32x2){R.x, R.y}, (f32x2){R.z, R.w});
                    yc = e.x + e.y;
                    if (ti >= 1) ykeep = (cg_ == ti - 1) ? yp : ykeep;
                    W = Wn; NK = NKn; B = Bn; KP = KPn; R = Rn; vv = vn;
                }
                const float y15 = rowsum16(yc);
                ykeep = (cg_ == 15) ? y15 : ykeep;
                YR[(size_t)(c * SCAN_T + hh * 16 + cg_) * 1024 + head * 64 + rbase + rl] = f2bf(ykeep);
            }
            SCAN_BAR(); }
    }
}

constexpr float QK_SCALE2 = 0.125f * 1.4426950408889634f;
struct Flash { float m, l; f32x4 o[4]; };
__device__ __forceinline__ void flash_init(Flash& f) { f.m = -1e30f; f.l = 0.f;
#pragma unroll
    for (int i = 0; i < 4; ++i) f.o[i] = (f32x4){0.f, 0.f, 0.f, 0.f}; }
struct KV64 { bf16x8 k[4][2]; bf16x8 v[2][4]; };
__device__ __forceinline__ void load_kv64(KV64& x, const bf16_t* Kp, const bf16_t* Vt, int kb, int col, int quad) {
#pragma unroll
    for (int a = 0; a < 4; ++a) { const bf16_t* kr = Kp + (size_t)((kb >> 4) + a) * 1024 + col * 32 + quad * 8; x.k[a][0] = *(const bf16x8*)kr; x.k[a][1] = *(const bf16x8*)(kr + 512); }
#pragma unroll
    for (int h = 0; h < 2; ++h)
#pragma unroll
        for (int dt = 0; dt < 4; ++dt) { const bf16_t* vr = Vt + (size_t)((kb >> 5) + h) * 2048 + dt * 512 + col * 32 + quad * 8; x.v[h][dt] = *(const bf16x8*)vr; }
}
__device__ __forceinline__ void flash_block64(Flash& f, const bf16x8 (&q)[2], const KV64& x, int kb, int lo, int hi, bool masked, int quad) {
    f32x4 s[4];
#pragma unroll
    for (int a = 0; a < 4; ++a) { s[a] = (f32x4){0.f, 0.f, 0.f, 0.f};
#pragma unroll
        for (int ks = 0; ks < 2; ++ks) s[a] = __builtin_amdgcn_mfma_f32_16x16x32_bf16(x.k[a][ks], q[ks], s[a], 0, 0, 0); }
    if (masked) {
#pragma unroll
        for (int a = 0; a < 4; ++a)
#pragma unroll
            for (int r = 0; r < 4; ++r) { const int key = kb + 16 * a + quad * 4 + r; s[a][r] = (key >= lo && key <= hi) ? s[a][r] : -1e30f; }
    }
    float mx = fmaxf(fmaxf(fmaxf(s[0][0], s[0][1]), fmaxf(s[0][2], s[0][3])), fmaxf(fmaxf(s[1][0], s[1][1]), fmaxf(s[1][2], s[1][3])));
    mx = fmaxf(mx, fmaxf(fmaxf(fmaxf(s[2][0], s[2][1]), fmaxf(s[2][2], s[2][3])), fmaxf(fmaxf(s[3][0], s[3][1]), fmaxf(s[3][2], s[3][3]))));
    mx = quad_allmax(mx) * QK_SCALE2;
    const float mn = fmaxf(f.m, mx);
    if (__ballot(mn != f.m) != 0ull) {
        const float alpha = __builtin_amdgcn_exp2f(f.m - mn); f.m = mn; f.l *= alpha;
#pragma unroll
        for (int dt = 0; dt < 4; ++dt) f.o[dt] *= alpha; }
    float ps = 0.f;
    if (masked) {
#pragma unroll
        for (int a = 0; a < 4; ++a)
#pragma unroll
            for (int r = 0; r < 4; ++r) { const float pv = s[a][r] > -1e29f ? __builtin_amdgcn_exp2f(__builtin_fmaf(s[a][r], QK_SCALE2, -mn)) : 0.f; s[a][r] = pv; ps += pv; }
    } else {
#pragma unroll
        for (int a = 0; a < 4; ++a)
#pragma unroll
            for (int r = 0; r < 4; ++r) { const float pv = __builtin_amdgcn_exp2f(__builtin_fmaf(s[a][r], QK_SCALE2, -mn)); s[a][r] = pv; ps += pv; }
    }
    f.l += ps;
    const bf16x8 p0 = pack8(s[0], s[1]), p1 = pack8(s[2], s[3]);
#pragma unroll
    for (int dt = 0; dt < 4; ++dt) { f.o[dt] = __builtin_amdgcn_mfma_f32_16x16x32_bf16(x.v[0][dt], p0, f.o[dt], 0, 0, 0); f.o[dt] = __builtin_amdgcn_mfma_f32_16x16x32_bf16(x.v[1][dt], p1, f.o[dt], 0, 0, 0); }
}
__device__ __forceinline__ void flash_block64v(Flash& f, const bf16x8 (&q)[2], const KV64& x, bool valid) {
    f32x4 s[4];
#pragma unroll
    for (int a = 0; a < 4; ++a) { s[a] = (f32x4){0.f, 0.f, 0.f, 0.f};
#pragma unroll
        for (int ks = 0; ks < 2; ++ks) s[a] = __builtin_amdgcn_mfma_f32_16x16x32_bf16(x.k[a][ks], q[ks], s[a], 0, 0, 0); }
    float mx = fmaxf(fmaxf(fmaxf(s[0][0], s[0][1]), fmaxf(s[0][2], s[0][3])), fmaxf(fmaxf(s[1][0], s[1][1]), fmaxf(s[1][2], s[1][3])));
    mx = fmaxf(mx, fmaxf(fmaxf(fmaxf(s[2][0], s[2][1]), fmaxf(s[2][2], s[2][3])), fmaxf(fmaxf(s[3][0], s[3][1]), fmaxf(s[3][2], s[3][3]))));
    mx = valid ? quad_allmax(mx) * QK_SCALE2 : f.m;
    const float mn = fmaxf(f.m, mx);
    if (__ballot(mn != f.m) != 0ull) {
        const float alpha = __builtin_amdgcn_exp2f(f.m - mn); f.m = mn; f.l *= alpha;
#pragma unroll
        for (int dt = 0; dt < 4; ++dt) f.o[dt] *= alpha; }
    float ps = 0.f;
#pragma unroll
    for (int a = 0; a < 4; ++a)
#pragma unroll
        for (int r = 0; r < 4; ++r) { const float pv = __builtin_amdgcn_exp2f(__builtin_fmaf(s[a][r], QK_SCALE2, -mn)); s[a][r] = pv; ps += pv; }
    f.l += valid ? ps : 0.f;
    const unsigned vm = valid ? 0xffffffffu : 0u;
    u32x4 p0 = __builtin_bit_cast(u32x4, pack8(s[0], s[1])), p1 = __builtin_bit_cast(u32x4, pack8(s[2], s[3]));
    p0.x &= vm; p0.y &= vm; p0.z &= vm; p0.w &= vm; p1.x &= vm; p1.y &= vm; p1.z &= vm; p1.w &= vm;
    const bf16x8 b0 = __builtin_bit_cast(bf16x8, p0), b1 = __builtin_bit_cast(bf16x8, p1);
#pragma unroll
    for (int dt = 0; dt < 4; ++dt) { f.o[dt] = __builtin_amdgcn_mfma_f32_16x16x32_bf16(x.v[0][dt], b0, f.o[dt], 0, 0, 0); f.o[dt] = __builtin_amdgcn_mfma_f32_16x16x32_bf16(x.v[1][dt], b1, f.o[dt], 0, 0, 0); }
}
__device__ __forceinline__ float flash_finish(const Flash& f) { const float l = quad_allsum(f.l); return l > 0.f ? 1.f / l : 0.f; }

constexpr int NSA_WLDS = 10240;

__device__ __forceinline__ void nsa_q(const bf16_t* FE, const float* ROPE, int tcol, int head, int quad, bf16x8 (&qn)[2], bf16x8 (&qr)[2]) {
    const bf16_t* qrow = FE + (size_t)tcol * IN_PAD + C_Q + head * 64;
    qn[0] = *(const bf16x8*)(qrow + quad * 8); qn[1] = *(const bf16x8*)(qrow + 32 + quad * 8);
    qr[0] = qn[0]; qr[1] = qn[1];
    if (quad < 2) { const bf16x8 ot = *(const bf16x8*)(qrow + (quad ^ 1) * 8); const float* cs = ROPE + (size_t)tcol * 16; float v[8];
#pragma unroll
        for (int i = 0; i < 8; ++i) { const float x = bf2f((bf16_t)qn[0][i]), y = bf2f((bf16_t)ot[i]); v[i] = quad == 0 ? x * cs[i] - y * cs[8 + i] : x * cs[i] + y * cs[8 + i]; }
        u32x4 o; o.x = pk2(v[0], v[1]); o.y = pk2(v[2], v[3]); o.z = pk2(v[4], v[5]); o.w = pk2(v[6], v[7]); qr[0] = __builtin_bit_cast(bf16x8, o); }
}
__device__ __forceinline__ void nsa_tile_pre(unsigned char* ws, LAS unsigned char* wl, LAS unsigned* blkmask, LAS unsigned char* kvb, int tid, int ncb, int t0, int g, int lane, f32x4 (&oc)[4]) {
    const bf16_t* FE = (const bf16_t*)(ws + OFF_ACT);
    LAS float* impA = (LAS float*)wl; LAS float* impB = impA + 1024; LAS int* sel = (LAS int*)(impB + 1024);
    const int col = lane & 15, quad = lane >> 4, tok = col >> 2, hl = col & 3, head = g * 4 + hl, tcol = t0 + tok;
    bf16x8 qn[2];
    { const bf16_t* qrow = FE + (size_t)tcol * IN_PAD + C_Q + head * 64; qn[0] = *(const bf16x8*)(qrow + quad * 8); qn[1] = *(const bf16x8*)(qrow + 32 + quad * 8); }
    const int nmax_col = tcol >= 31 ? (tcol - 31) >> 4 : -1;
    const bf16_t* KC = (const bf16_t*)(ws + OFF_KCMP) + (size_t)g * 1024 * 64;
    const bf16_t* VCT = (const bf16_t*)(ws + OFF_VCMPT) + (size_t)g * 64 * 1024;
    float ml = -1e30f, ll = 0.f;
    __syncthreads();
    { const u32x4 k0 = *(const u32x4*)(KC + tid * 8); *(LAS u32x4*)(kvb + tid * 16) = k0; }
    u32x4 rkA = {0u, 0u, 0u, 0u}, rkB = rkA, rvA = rkA, rvB = rkA;
    if (1 < ncb) rkA = *(const u32x4*)(KC + (size_t)1 * 4096 + tid * 8);
    if (2 < ncb) rkB = *(const u32x4*)(KC + (size_t)2 * 4096 + tid * 8);
    __syncthreads();
#define CMP1_STEP(jc, RK) if ((jc) < ncb) { \
        LAS unsigned char* cb = kvb + ((jc) & 1) * 16384; LAS unsigned char* nb = kvb + (((jc) + 1) & 1) * 16384; \
        _Pragma("unroll") for (int hf = 0; hf < 2; ++hf) { const int kb = (jc) * 64 + hf * 32; float sv[8]; float mx = -1e30f; \
            _Pragma("unroll") for (int a = 0; a < 2; ++a) { f32x4 s = {0.f, 0.f, 0.f, 0.f}; \
                _Pragma("unroll") for (int ks = 0; ks < 2; ++ks) { const bf16x8 kf = *(const LAS bf16x8*)(cb + (((2 * hf + a) * 2 + ks) * 512 + col * 32 + quad * 8) * 2); s = __builtin_amdgcn_mfma_f32_16x16x32_bf16(kf, qn[ks], s, 0, 0, 0); } \
                _Pragma("unroll") for (int r = 0; r < 4; ++r) { const int n = kb + 16 * a + quad * 4 + r; sv[a * 4 + r] = n <= nmax_col ? s[r] * QK_SCALE2 : -1e30f; mx = fmaxf(mx, sv[a * 4 + r]); } } \
            const float mn = fmaxf(ml, mx); float ps = 0.f; \
            _Pragma("unroll") for (int i = 0; i < 8; ++i) ps += sv[i] > -1e29f ? __builtin_amdgcn_exp2f(sv[i] - mn) : 0.f; \
            ll = ll * __builtin_amdgcn_exp2f(ml - mn) + ps; ml = mn; } \
        if ((jc) + 1 < ncb) *(LAS u32x4*)(nb + tid * 16) = RK; \
        if ((jc) + 3 < ncb) RK = *(const u32x4*)(KC + (size_t)((jc) + 3) * 4096 + tid * 8); \
        SCAN_BAR(); }
    for (int jc = 0; jc < ncb; jc += 2) { CMP1_STEP(jc, rkA) CMP1_STEP(jc + 1, rkB) }
#undef CMP1_STEP
    const float M = quad_allmax(ml);
    const float L = quad_allsum(ll * __builtin_amdgcn_exp2f(ml - M));
    const float invL = L > 0.f ? 1.f / L : 0.f;
#pragma unroll
    for (int i = 0; i < 32; ++i) impA[i * 64 + lane] = 0.f;
    LDS_WAIT();
#pragma unroll
    for (int i = 0; i < 4; ++i) oc[i] = (f32x4){0.f, 0.f, 0.f, 0.f};
    __syncthreads();
    { const u32x4 k0 = *(const u32x4*)(KC + tid * 8), v0 = *(const u32x4*)(VCT + tid * 8); *(LAS u32x4*)(kvb + tid * 16) = k0; *(LAS u32x4*)(kvb + 8192 + tid * 16) = v0; }
    if (1 < ncb) { rkA = *(const u32x4*)(KC + (size_t)1 * 4096 + tid * 8); rvA = *(const u32x4*)(VCT + (size_t)1 * 4096 + tid * 8); }
    if (2 < ncb) { rkB = *(const u32x4*)(KC + (size_t)2 * 4096 + tid * 8); rvB = *(const u32x4*)(VCT + (size_t)2 * 4096 + tid * 8); }
    __syncthreads();
#define CMP2_STEP(jc, RK, RV) if ((jc) < ncb) { \
        LAS unsigned char* cb = kvb + ((jc) & 1) * 16384; LAS unsigned char* nb = kvb + (((jc) + 1) & 1) * 16384; \
        _Pragma("unroll") for (int hf = 0; hf < 2; ++hf) { const int kb = (jc) * 64 + hf * 32; f32x4 pr[2]; \
            _Pragma("unroll") for (int a = 0; a < 2; ++a) { f32x4 s = {0.f, 0.f, 0.f, 0.f}; \
                _Pragma("unroll") for (int ks = 0; ks < 2; ++ks) { const bf16x8 kf = *(const LAS bf16x8*)(cb + (((2 * hf + a) * 2 + ks) * 512 + col * 32 + quad * 8) * 2); s = __builtin_amdgcn_mfma_f32_16x16x32_bf16(kf, qn[ks], s, 0, 0, 0); } \
                _Pragma("unroll") for (int r = 0; r < 4; ++r) { const int n = kb + 16 * a + quad * 4 + r; pr[a][r] = n <= nmax_col ? __builtin_amdgcn_exp2f(s[r] * QK_SCALE2 - M) * invL : 0.f; } } \
            const bf16x8 pf = pack8(pr[0], pr[1]); \
            _Pragma("unroll") for (int dt = 0; dt < 4; ++dt) { const bf16x8 vf = *(const LAS bf16x8*)(cb + 8192 + (hf * 2048 + dt * 512 + col * 32 + quad * 8) * 2); \
                oc[dt] = __builtin_amdgcn_mfma_f32_16x16x32_bf16(vf, pf, oc[dt], 0, 0, 0); } \
            _Pragma("unroll") for (int a = 0; a < 2; ++a) { float s4 = (pr[a][0] + pr[a][1]) + (pr[a][2] + pr[a][3]), p3 = pr[a][3]; \
                s4 += dppf<0xB1>(s4); s4 += dppf<0x4E>(s4); p3 += dppf<0xB1>(p3); p3 += dppf<0x4E>(p3); \
                const int jj = ((kb + 16 * a) >> 2) + quad; \
                if (hl == 0 && jj < 256) { impA[tok * 256 + jj] = s4; if (jj + 1 < 256) impB[tok * 256 + jj + 1] = p3; } } } \
        if ((jc) + 1 < ncb) { *(LAS u32x4*)(nb + tid * 16) = RK; *(LAS u32x4*)(nb + 8192 + tid * 16) = RV; } \
        if ((jc) + 3 < ncb) { RK = *(const u32x4*)(KC + (size_t)((jc) + 3) * 4096 + tid * 8); RV = *(const u32x4*)(VCT + (size_t)((jc) + 3) * 4096 + tid * 8); } \
        SCAN_BAR(); }
    for (int jc = 0; jc < ncb; jc += 2) { CMP2_STEP(jc, rkA, rvA) CMP2_STEP(jc + 1, rkB, rvB) }
#undef CMP2_STEP
    LDS_WAIT();
    for (int tk = 0; tk < 4; ++tk) { const int t = t0 + tk, cur = t >> 6; int cnt = 0;
        if (lane == 0) { sel[tk * 16 + 0] = 0; if (cur >= 1) sel[tk * 16 + 1] = cur; if (cur >= 2) sel[tk * 16 + 2] = cur - 1; }
        cnt = cur == 0 ? 1 : (cur == 1 ? 2 : 3);
        const int ncand = cur >= 2 ? cur - 2 : 0, nfree = 16 - cnt;
        if (ncand <= nfree) { if (lane < ncand) sel[tk * 16 + cnt + lane] = 1 + lane; cnt += ncand; }
        else { float v[4];
#pragma unroll
            for (int i = 0; i < 4; ++i) { const int j = lane * 4 + i; v[i] = (j >= 1 && j <= cur - 2) ? impA[tk * 256 + j] + impB[tk * 256 + j] : -1.f; }
            for (int rd = 0; rd < nfree; ++rd) { float bv = v[0]; int bi = 0;
#pragma unroll
                for (int i = 1; i < 4; ++i) if (v[i] > bv) { bv = v[i]; bi = i; }
                const float mx = wave_max(bv);
                const unsigned long long bal = __ballot(bv == mx); const int fl = __ffsll((long long)bal) - 1;
                const int bj = __shfl(lane * 4 + bi, fl);
                if (lane == fl) {
#pragma unroll
                    for (int i = 0; i < 4; ++i) if (i == bi) v[i] = -2.f; }
                if (lane == 0) sel[tk * 16 + cnt + rd] = bj; }
            cnt = 16; }
        LDS_WAIT();
        if (lane < cnt) { const int j = sel[tk * 16 + lane]; const int ti = (t0 & 63) + tk;
            __hip_atomic_fetch_or(blkmask + 2 * j + (ti >> 5), 1u << (ti & 31), __ATOMIC_RELAXED, __HIP_MEMORY_SCOPE_WORKGROUP); } }
    LDS_WAIT();
}
__device__ __forceinline__ void nsa_tile_add(unsigned char* ws, int t0, int g, int lane, const Flash& fb, int gi) {
    const bf16_t* FE = (const bf16_t*)(ws + OFF_ACT);
    const int col = lane & 15, quad = lane >> 4, tok = col >> 2, hl = col & 3, head = g * 4 + hl, tcol = t0 + tok;
    const float gb = sigmoidf_(bf2f(FE[(size_t)tcol * IN_PAD + C_GL + gi + head])) * flash_finish(fb);
    bf16_t* yo = (bf16_t*)(ws + OFF_XN) + (size_t)tcol * D_ + 1024 + head * 64 + quad * 4;
#pragma unroll
    for (int dt = 0; dt < 4; ++dt) { const u32x2 pc = *(const u32x2*)(yo + dt * 16);
        f32x4 o = gb * fb.o[dt];
        o[0] += __uint_as_float(pc.x << 16); o[1] += __uint_as_float(pc.x & 0xffff0000u); o[2] += __uint_as_float(pc.y << 16); o[3] += __uint_as_float(pc.y & 0xffff0000u);
        u32x2 v; v.x = pk2(o[0], o[1]); v.y = pk2(o[2], o[3]); *(u32x2*)(yo + dt * 16) = v; }
}
constexpr int NI_MASK = 0, NI_ID = 2048, NI_KV = 4096, NI_KVB = 4096 + 8 * NSA_WLDS;
__device__ __forceinline__ void nsa_item(unsigned char* ws, LAS unsigned char* lds, int qb, int g, int wave, int lane) {
    asm volatile("" : "+v"(lane));
    const bf16_t* FE = (const bf16_t*)(ws + OFF_ACT); const float* ROPE = (const float*)(ws + OFF_ROPE);
    LAS unsigned* blkmask = (LAS unsigned*)(lds + NI_MASK);
    LAS unsigned char* wl = lds + NI_KV + wave * NSA_WLDS;
    const int tid = wave * 64 + lane, col = lane & 15, quad = lane >> 4, tok = col >> 2, hl = col & 3, head = g * 4 + hl;
    const int tw = qb * 64 + wave * 8;
    blkmask[tid] = 0u;
    __syncthreads();
    for (int c = 0; c < 2; ++c) {
        f32x4 oc[4]; const int t0 = tw + 4 * c;
        nsa_tile_pre(ws, wl, blkmask, lds + NI_KVB, tid, ((4 * qb + 2) >> 6) + 1, t0, g, lane, oc);
        const float gc = sigmoidf_(bf2f(FE[(size_t)(t0 + tok) * IN_PAD + C_GL + head]));
        bf16_t* yo = (bf16_t*)(ws + OFF_XN) + (size_t)(t0 + tok) * D_ + 1024 + head * 64 + quad * 4;
#pragma unroll
        for (int dt = 0; dt < 4; ++dt) { u32x2 v; v.x = pk2(gc * oc[dt][0], gc * oc[dt][1]); v.y = pk2(gc * oc[dt][2], gc * oc[dt][3]); *(u32x2*)(yo + dt * 16) = v; } }
    __syncthreads();
    const bf16_t* KS = (const bf16_t*)(ws + OFF_KSR) + (size_t)g * S_ * 64;
    const bf16_t* VS = (const bf16_t*)(ws + OFF_VST) + (size_t)g * S_ * 64;
    LAS unsigned char* kvb = lds + NI_KVB;
    {
        bf16x8 qn[2], qr0[2], qr1[2];
        nsa_q(FE, ROPE, tw + tok, head, quad, qn, qr0);
        nsa_q(FE, ROPE, tw + 4 + tok, head, quad, qn, qr1);
        Flash f0, f1; flash_init(f0); flash_init(f1);
        __syncthreads();
        { const u32x4 k0 = *(const u32x4*)(KS + tid * 8), v0 = *(const u32x4*)(VS + tid * 8);
          *(LAS u32x4*)(kvb + tid * 16) = k0; *(LAS u32x4*)(kvb + 8192 + tid * 16) = v0; }
        u32x4 rk = {0u, 0u, 0u, 0u}, rv = rk;
        __syncthreads();
        for (int j = 0; j <= qb; ++j) {
            LAS unsigned char* cb = kvb + (j & 1) * 16384; LAS unsigned char* nb = kvb + ((j + 1) & 1) * 16384;
            if (j < qb) { rk = *(const u32x4*)(KS + (size_t)(j + 1) * 4096 + tid * 8); rv = *(const u32x4*)(VS + (size_t)(j + 1) * 4096 + tid * 8); }
            unsigned my8 = 0xFFu;
            if (j < qb) { const unsigned mw = __builtin_amdgcn_readfirstlane(blkmask[2 * j + (wave >> 2)]); my8 = (mw >> ((wave & 3) * 8)) & 0xFFu; }
            if (my8) {
                KV64 x;
#pragma unroll
                for (int a = 0; a < 4; ++a)
#pragma unroll
                    for (int ks = 0; ks < 2; ++ks) x.k[a][ks] = *(const LAS bf16x8*)(cb + ((a * 2 + ks) * 512 + col * 32 + quad * 8) * 2);
#pragma unroll
                for (int h = 0; h < 2; ++h)
#pragma unroll
                    for (int dt = 0; dt < 4; ++dt) x.v[h][dt] = *(const LAS bf16x8*)(cb + 8192 + (h * 2048 + dt * 512 + col * 32 + quad * 8) * 2);
                const unsigned b0 = my8 & 0xFu, b1 = my8 >> 4;
                if (j < qb) { if (b0) flash_block64v(f0, qr0, x, (b0 >> tok) & 1u); if (b1) flash_block64v(f1, qr1, x, (b1 >> tok) & 1u); }
                else { flash_block64(f0, qr0, x, qb * 64, 0, tw + tok, true, quad); flash_block64(f1, qr1, x, qb * 64, 0, tw + 4 + tok, true, quad); }
            }
            if (j < qb) { *(LAS u32x4*)(nb + tid * 16) = rk; *(LAS u32x4*)(nb + 8192 + tid * 16) = rv; }
            SCAN_BAR();
        }
        nsa_tile_add(ws, tw, g, lane, f0, 16); nsa_tile_add(ws, tw + 4, g, lane, f1, 16);
        flash_init(f0); flash_init(f1);
        { const bf16_t* KW = (const bf16_t*)(ws + OFF_KWR) + (size_t)g * S_ * 64;
          const bf16_t* VW = (const bf16_t*)(ws + OFF_VWT) + (size_t)g * S_ * 64;
          const int jw0 = qb >= 8 ? qb - 8 : 0;
          __syncthreads();
          rk = *(const u32x4*)(KW + (size_t)jw0 * 4096 + tid * 8); rv = *(const u32x4*)(VW + (size_t)jw0 * 4096 + tid * 8);
          *(LAS u32x4*)(kvb + (jw0 & 1) * 16384 + tid * 16) = rk; *(LAS u32x4*)(kvb + (jw0 & 1) * 16384 + 8192 + tid * 16) = rv;
          __syncthreads();
          for (int j = jw0; j <= qb; ++j) {
              LAS unsigned char* cb = kvb + (j & 1) * 16384; LAS unsigned char* nb = kvb + ((j + 1) & 1) * 16384;
              if (j < qb) { rk = *(const u32x4*)(KW + (size_t)(j + 1) * 4096 + tid * 8); rv = *(const u32x4*)(VW + (size_t)(j + 1) * 4096 + tid * 8); }
              KV64 x;
#pragma unroll
              for (int a = 0; a < 4; ++a)
#pragma unroll
                  for (int ks = 0; ks < 2; ++ks) x.k[a][ks] = *(const LAS bf16x8*)(cb + ((a * 2 + ks) * 512 + col * 32 + quad * 8) * 2);
#pragma unroll
              for (int h = 0; h < 2; ++h)
#pragma unroll
                  for (int dt = 0; dt < 4; ++dt) x.v[h][dt] = *(const LAS bf16x8*)(cb + 8192 + (h * 2048 + dt * 512 + col * 32 + quad * 8) * 2);
              if (j == qb || j + 8 == qb) { flash_block64(f0, qr0, x, j * 64, tw + tok - 511, tw + tok, true, quad); flash_block64(f1, qr1, x, j * 64, tw + 4 + tok - 511, tw + 4 + tok, true, quad); }
              else { flash_block64v(f0, qr0, x, true); flash_block64v(f1, qr1, x, true); }
              if (j < qb) { *(LAS u32x4*)(nb + tid * 16) = rk; *(LAS u32x4*)(nb + 8192 + tid * 16) = rv; }
              SCAN_BAR();
          } }
        nsa_tile_add(ws, tw, g, lane, f0, 32); nsa_tile_add(ws, tw + 4, g, lane, f1, 32);
    }
}

__device__ __forceinline__ void mem_attn_task(unsigned char* ws, int task, int lane) {
    const int h = task & 3, t0 = (task >> 2) * 16, col = lane & 15, quad = lane >> 4;
    const bf16_t* QM = (const bf16_t*)(ws + OFF_QM); const bf16_t* KM = (const bf16_t*)(ws + OFF_KM); const bf16_t* VMT = (const bf16_t*)(ws + OFF_VMT);
    bf16x8 q[4];
#pragma unroll
    for (int ks = 0; ks < 4; ++ks) q[ks] = *(const bf16x8*)(QM + (size_t)(t0 + col) * 512 + h * 128 + ks * 32 + quad * 8);
    float m = -1e30f, l = 0.f; f32x4 o[8];
#pragma unroll
    for (int i = 0; i < 8; ++i) o[i] = (f32x4){0.f, 0.f, 0.f, 0.f};
    const float sc = 0.08838834764831845f;
    for (int kb = 0; kb < 256; kb += 32) { f32x4 s[2]; float mx = -1e30f;
#pragma unroll
        for (int a = 0; a < 2; ++a) { s[a] = (f32x4){0.f, 0.f, 0.f, 0.f}; const bf16_t* kr = KM + (size_t)(kb + 16 * a + col) * 512 + h * 128 + quad * 8;
#pragma unroll
            for (int ks = 0; ks < 4; ++ks) { const bf16x8 kf = *(const bf16x8*)(kr + ks * 32); s[a] = __builtin_amdgcn_mfma_f32_16x16x32_bf16(kf, q[ks], s[a], 0, 0, 0); }
#pragma unroll
            for (int r = 0; r < 4; ++r) { s[a][r] *= sc; mx = fmaxf(mx, s[a][r]); } }
        mx = fmaxf(mx, __shfl_xor(mx, 16)); mx = fmaxf(mx, __shfl_xor(mx, 32));
        const float mn = fmaxf(m, mx), alpha = __expf(m - mn); m = mn; float ps = 0.f;
#pragma unroll
        for (int a = 0; a < 2; ++a)
#pragma unroll
            for (int r = 0; r < 4; ++r) { s[a][r] = __expf(s[a][r] - mn); ps += s[a][r]; }
        l = l * alpha + ps;
        const bf16x8 pf = pack8(s[0], s[1]);
#pragma unroll
        for (int dt = 0; dt < 8; ++dt) { const bf16_t* vr = VMT + (size_t)(h * 128 + dt * 16 + col) * 256 + kb + quad * 4; const bf16x8 vf = ld2x4(vr, vr + 16);
            o[dt] *= alpha; o[dt] = __builtin_amdgcn_mfma_f32_16x16x32_bf16(vf, pf, o[dt], 0, 0, 0); } }
    l += __shfl_xor(l, 16); l += __shfl_xor(l, 32); const float inv = 1.f / l;
    bf16_t* om = (bf16_t*)(ws + OFF_OM) + (size_t)(t0 + col) * 512 + h * 128 + quad * 4;
#pragma unroll
    for (int dt = 0; dt < 8; ++dt) { u32x2 v; v.x = pk2(o[dt][0] * inv, o[dt][1] * inv); v.y = pk2(o[dt][2] * inv, o[dt][3] * inv); *(u32x2*)(om + dt * 16) = v; }
}


__device__ __forceinline__ void gsync(unsigned* bar, unsigned target, int wave_s) {
    asm volatile("s_waitcnt vmcnt(0) lgkmcnt(0)" ::: "memory");
    __syncthreads();
    if (wave_s == 0) { int lane; asm volatile("v_mbcnt_lo_u32_b32 %0, -1, 0\n\tv_mbcnt_hi_u32_b32 %0, -1, %0" : "=v"(lane));
        if (lane == 0) { __builtin_amdgcn_fence(__ATOMIC_RELEASE, "agent");
            asm volatile("s_waitcnt vmcnt(0)" ::: "memory");
            __hip_atomic_fetch_add(bar, 1u, __ATOMIC_RELAXED, __HIP_MEMORY_SCOPE_AGENT);
            while (__hip_atomic_load(bar, __ATOMIC_RELAXED, __HIP_MEMORY_SCOPE_AGENT) < target) __builtin_amdgcn_s_sleep(20); } }
    __syncthreads();
    __builtin_amdgcn_fence(__ATOMIC_ACQUIRE, "agent");
    asm volatile("s_waitcnt vmcnt(0)" ::: "memory");
}
__device__ __forceinline__ void ffn_phases(unsigned* bar, unsigned& bar_t, LAS unsigned char* lds, unsigned char* ws, bf16_t* XN, bf16_t* ACT, bf16_t* Y, int G, int bid, const int wave_s) {
    { pg8::StaticOrder so; so.init(S_, 2 * FF_, G, bid);
      pg8::Gemm g{XN, (const bf16_t*)(ws + OFF_WGU), S_, 2 * FF_, D_};
      pg8::EpiSwiGLU e{ACT, FF_};
      pg8::gemm_phase(lds, g, so, e, wave_s); }
    bar_t += G; gsync(bar, bar_t, wave_s);
    { pg8::StaticOrder so; so.init(S_, D_, G, bid);
      pg8::Gemm g{ACT, (const bf16_t*)(ws + OFF_WD), S_, D_, FF_};
      pg8::EpiBf16 e{Y, D_};
      pg8::gemm_phase(lds, g, so, e, wave_s); }
    bar_t += G; gsync(bar, bar_t, wave_s);
}

__global__ void __launch_bounds__(512, 2) hymba_fwd(Params p) {
    extern __shared__ __attribute__((aligned(16))) unsigned char shm[];
    cg::grid_group grid = cg::this_grid();
    LAS unsigned char* lds = (LAS unsigned char*)shm;
    const int G = gridDim.x, bid = blockIdx.x;
    const int NGW = G * 8, NT = G * 512;
    unsigned char* ws = p.ws;
    bf16_t* XN = (bf16_t*)(ws + OFF_XN);
    bf16_t* ACT = (bf16_t*)(ws + OFF_ACT);
    bf16_t* Y = (bf16_t*)(ws + OFF_Y);
    unsigned* ctr = (unsigned*)(ws + OFF_CTR);
    unsigned* bar = ctr + 64; unsigned bar_t = 0;
    const int wave_s = __builtin_amdgcn_readfirstlane(threadIdx.x >> 6);
#define PHASE_IDX() int lane; asm volatile("v_mbcnt_lo_u32_b32 %0, -1, 0\n\tv_mbcnt_hi_u32_b32 %0, -1, %0" : "=v"(lane)); const int wave = wave_s; const int tid = wave * 64 + lane; (void)tid; const int gw = bid * 8 + wave, gtid = bid * 512 + tid; (void)gtid; (void)gw; (void)lane; LAS float* scr = (LAS float*)(lds + wave * 16384); (void)scr;

    {
        PHASE_IDX();
        conv_gateup(p.in[3], p.in[4], (bf16_t*)(ws + OFF_WGU), scr, lane, gw, NGW);
        conv_plain(p.in[5], FF_, D_, D_, (bf16_t*)(ws + OFF_WD), scr, lane, gw, NGW);
        conv_plain(p.in[8], D_, IN_COLS, IN_PAD, (bf16_t*)(ws + OFF_WIN), scr, lane, gw, NGW);
        conv_plain(p.in[26], D_, D_, D_, (bf16_t*)(ws + OFF_WOUT), scr, lane, gw, NGW);
        conv_plain(p.in[30], D_, 512, 512, (bf16_t*)(ws + OFF_WMQ), scr, lane, gw, NGW);
        conv_plain(p.in[32], 512, D_, D_, (bf16_t*)(ws + OFF_WMO), scr, lane, gw, NGW);
        conv_plain(p.in[31], D_, 1024, 1024, (bf16_t*)(ws + OFF_WMKV), scr, lane, gw, NGW);
        conv_plain(p.in[21], 2048, 128, 128, (bf16_t*)(ws + OFF_WC1K), scr, lane, gw, NGW);
        conv_plain(p.in[24], 2048, 128, 128, (bf16_t*)(ws + OFF_WC1V), scr, lane, gw, NGW);
        conv_plain(p.in[22], 128, 64, 64, (bf16_t*)(ws + OFF_WC2K), scr, lane, gw, NGW);
        conv_plain(p.in[25], 128, 64, 64, (bf16_t*)(ws + OFF_WC2V), scr, lane, gw, NGW);
        for (int row = gw; row < S_; row += NGW) rms_row_to_bf16(p.in[0] + (size_t)row * D_, p.in[2], XN + (size_t)row * D_, lane);
        for (int row = gw; row < MEM_; row += NGW) rms_row_to_bf16(p.in[1] + (size_t)row * D_, p.in[29], (bf16_t*)(ws + OFF_MEMN) + (size_t)row * D_, lane);
        { bf16_t* WL = (bf16_t*)(ws + OFF_WLORA);
          for (int i = gtid; i < LORA_N * LORA_K; i += NT) { const int n = i / LORA_K, k = i % LORA_K; float v = 0.f;
              if (n < 1024) { if (k < 64) v = p.in[11][k * 1024 + n]; }
              else if (n < 2048) { if (k >= 64 && k < 128) v = p.in[13][(k - 64) * 1024 + n - 1024]; }
              else { if (k >= 128 && k < 288) v = p.in[14][(k - 128) * 1024 + n - 2048]; }
              WL[i] = f2bf(v); } }
        { float* RP = (float*)(ws + OFF_ROPE);
          for (int i = gtid; i < S_ * 8; i += NT) { const int pos = i >> 3, f = i & 7;
              const float fr = f == 0 ? 1.000000000e+00f : f == 1 ? 1.939227432e-01f : f == 2 ? 3.760603070e-02f : f == 3 ? 7.292664610e-03f : f == 4 ? 1.414213562e-03f : f == 5 ? 2.742481884e-04f : f == 6 ? 5.318296098e-05f : 1.031338616e-05f;
              const float ang = (float)pos * fr;
              const double rev = (double)ang * 0.15915494309189535; const double fc = rev - rint(rev);
              const float rr = (float)(fc * 6.283185307179586);
              RP[pos * 16 + f] = cosf(rr); RP[pos * 16 + 8 + f] = sinf(rr); } }
    }
    grid.sync();
    ffn_phases(bar, bar_t, lds, ws, XN, ACT, Y, G, bid, wave_s);
    { PHASE_IDX(); norm_phase(p.in[0], Y, 0.5f, p.in[6], p.out, p.in[7], XN, lane, gw, NGW); }
    bar_t += G; gsync(bar, bar_t, wave_s);
    { pg8::StaticOrder so; so.init(S_, IN_PAD, G, bid);
      pg8::Gemm g{XN, (const bf16_t*)(ws + OFF_WIN), S_, IN_PAD, D_};
      pg8::EpiBf16 e{ACT, IN_PAD};
      pg8::gemm_phase(lds, g, so, e, wave_s); }
    bar_t += G; gsync(bar, bar_t, wave_s);
    {
        PHASE_IDX();
        const bf16_t* FE = ACT;
        if (wave < 2) { for (int task = bid * 2 + wave; task < 512; task += G * 2) compress_task(p, ws, task, lane); }
        else {
        const int gtid = (bid * 6 + wave - 2) * 64 + lane, NT = G * 384;
        { float* KN2 = (float*)(ws + OFF_KN2);
          for (int pr = bid * 6 + wave - 2; pr < S_ * 16; pr += G * 6) { const int t = pr >> 4, c = (pr & 15) * 64 + lane;
              const float kx = shiftv(FE, t, C_K + c, p.in[9][C_K + c]) * p.in[15][c]; const float ss = wave_sum(kx * kx);
              if (lane == 0) KN2[pr] = 1.f / fmaxf(sqrtf(ss), 1e-12f); } }
        { bf16_t* XL = (bf16_t*)(ws + OFF_XL);
          for (int i = gtid; i < S_ * LORA_K; i += NT) { const int t = i / LORA_K, c = i % LORA_K; float v = 0.f;
              if (c < 288) { const float s = shiftv(FE, t, C_WD + c, p.in[9][C_WD + c]); v = c < 64 ? tanhf_(s) : (c < 128 ? s : sigmoidf_(s)); }
              XL[i] = f2bf(v); } }
        { const float* RP = (const float*)(ws + OFF_ROPE);
          for (int i = gtid; i < S_ * 4 * 2; i += NT) { const int which = i & 1, g = (i >> 1) & 3, t = i >> 3;
              const bf16_t* srcp = FE + (size_t)t * IN_PAD + (which ? C_KW : C_KS) + g * 64;
              bf16_t* dstp = (bf16_t*)(ws + (which ? OFF_KWR : OFF_KSR)) + ((size_t)g * (S_ / 16) + (t >> 4)) * 1024 + (t & 15) * 32;
              const bf16x8 a = *(const bf16x8*)srcp, b = *(const bf16x8*)(srcp + 8); const float* cs = RP + (size_t)t * 16; float va[8], vb[8];
#pragma unroll
              for (int j = 0; j < 8; ++j) { const float x1 = bf2f((bf16_t)a[j]), x2 = bf2f((bf16_t)b[j]); va[j] = x1 * cs[j] - x2 * cs[8 + j]; vb[j] = x2 * cs[j] + x1 * cs[8 + j]; }
              u32x4 o; o.x = pk2(va[0], va[1]); o.y = pk2(va[2], va[3]); o.z = pk2(va[4], va[5]); o.w = pk2(va[6], va[7]); *(u32x4*)dstp = o;
              o.x = pk2(vb[0], vb[1]); o.y = pk2(vb[2], vb[3]); o.z = pk2(vb[4], vb[5]); o.w = pk2(vb[6], vb[7]); *(u32x4*)(dstp + 8) = o;
#pragma unroll
              for (int j = 2; j < 8; ++j) *(u32x4*)(dstp + (j >> 2) * 512 + (j & 3) * 8) = *(const u32x4*)(srcp + j * 8); } }
        { for (int i = gtid; i < 2 * 256 * (S_ / 8); i += NT) { const int gd = i & 255, which = (i >> 8) & 1, tc = i >> 9;
              const bf16_t* srcp = FE + (size_t)tc * 8 * IN_PAD + (which ? C_VW : C_VS) + gd;
              bf16_t v[8];
#pragma unroll
              for (int j = 0; j < 8; ++j) v[j] = srcp[(size_t)j * IN_PAD];
              u32x4 o; o.x = v[0] | ((unsigned)v[1] << 16); o.y = v[2] | ((unsigned)v[3] << 16); o.z = v[4] | ((unsigned)v[5] << 16); o.w = v[6] | ((unsigned)v[7] << 16);
              bf16_t* dv = (bf16_t*)(ws + (which ? OFF_VWT : OFF_VST)) + (((size_t)(gd >> 6) * (S_ / 32) + (tc >> 2)) * 4 + ((gd & 63) >> 4)) * 512 + (gd & 15) * 32 + (tc & 1) * 16 + ((tc & 3) >> 1) * 4;
              u32x2 lo2; lo2.x = o.x; lo2.y = o.y; u32x2 hi2; hi2.x = o.z; hi2.y = o.w; *(u32x2*)dv = lo2; *(u32x2*)(dv + 8) = hi2; } }
        }
    }
    bar_t += G; gsync(bar, bar_t, wave_s);
    { pg8::StaticOrder so; so.init(S_, LORA_N, G, bid);
      pg8::Gemm g{(const bf16_t*)(ws + OFF_XL), (const bf16_t*)(ws + OFF_WLORA), S_, LORA_N, LORA_K};
      EpiLora e{(bf16_t*)(ws + OFF_LORA), p.in[10], p.in[12]};
      pg8::gemm_phase(lds, g, so, e, wave_s); }
    bar_t += G; gsync(bar, bar_t, wave_s);
    { PHASE_IDX();
    if (bid < 64) { rwkv_scan_block(p, ws, lds, bid, tid); }
    { {
        const int g0 = (int)(__builtin_amdgcn_s_getreg((3 << 11) | 20) & 3u);
        LAS unsigned* idw = (LAS unsigned*)(lds + NI_ID);
        for (int gi = 0; gi < 4; ++gi) { const int g = (g0 + gi) & 3;
          for (;;) { __syncthreads();
            if (tid == 0) *idw = atomicAdd(ctr + g, 1u);
            __syncthreads();
            const unsigned id = __builtin_amdgcn_readfirstlane(*idw);
            if (id >= (unsigned)(S_ / 64)) break;
            nsa_item(ws, lds, (S_ / 64 - 1) - (int)id, g, wave, lane); } } }
    } }
    bar_t += G; gsync(bar, bar_t, wave_s);
    {
        PHASE_IDX();
        const bf16_t* FE = ACT; const bf16_t* LO = (const bf16_t*)(ws + OFF_LORA); const bf16_t* YR = (const bf16_t*)(ws + OFF_YRAW);
        for (int task = gw; task < S_ * 4; task += NGW) { const int t4 = (task >> 4) * 4, h = task & 15, c = h * 64 + lane;
            const float mu_r = p.in[9][C_R + c], mu_k = p.in[9][C_K + c], mu_v = p.in[9][C_V + c], lnw = p.in[18][c], lnb = p.in[19][c], kaw = p.in[16][c], rkw = p.in[17][c];
            float fr[5], fk[5], fv[5], yy[4], aa[4], gg[4];
#pragma unroll
            for (int i = 0; i < 5; ++i) { const int t = t4 - 1 + i;
                if (t >= 0) { fr[i] = bf2f(FE[(size_t)t * IN_PAD + C_R + c]); fk[i] = bf2f(FE[(size_t)t * IN_PAD + C_K + c]); fv[i] = bf2f(FE[(size_t)t * IN_PAD + C_V + c]); }
                else { fr[i] = 0.f; fk[i] = 0.f; fv[i] = 0.f; } }
#pragma unroll
            for (int i = 0; i < 4; ++i) { const int t = t4 + i; yy[i] = bf2f(YR[(size_t)t * 1024 + c]); aa[i] = bf2f(LO[(size_t)t * LORA_N + 1024 + c]); gg[i] = bf2f(LO[(size_t)t * LORA_N + 2048 + c]); }
#pragma unroll
            for (int i = 0; i < 4; ++i) {
                const float y = yy[i]; const float mean = wave_sum(y) * (1.f / 64.f); const float d = y - mean; const float var = wave_sum(d * d) * (1.f / 64.f);
                const float yn = d * rsqrtf(var + 64e-5f) * lnw + lnb;
                const float r = fr[i + 1] + mu_r * (fr[i] - fr[i + 1]), k = fk[i + 1] + mu_k * (fk[i] - fk[i + 1]), v = fv[i + 1] + mu_v * (fv[i] - fv[i + 1]);
                const float kp = k * (1.f + (aa[i] - 1.f) * kaw);
                const float bonus = wave_sum(r * kp * rkw) * v;
                XN[(size_t)(t4 + i) * D_ + c] = f2bf((yn + bonus) * gg[i]); } }
    }
    bar_t += G; gsync(bar, bar_t, wave_s);
    { pg8::StaticOrder so; so.init(S_, D_, G, bid);
      pg8::Gemm g{XN, (const bf16_t*)(ws + OFF_WOUT), S_, D_, D_};
      pg8::EpiBf16 e{Y, D_};
      pg8::gemm_phase(lds, g, so, e, wave_s); }
    bar_t += G; gsync(bar, bar_t, wave_s);
    { PHASE_IDX();
    norm_phase(p.out, Y, 1.0f, p.in[27], p.out, p.in[28], XN, lane, gw, NGW);
    conv_gateup(p.in[35], p.in[36], (bf16_t*)(ws + OFF_WGU), scr, lane, gw, NGW);
    conv_plain(p.in[37], FF_, D_, D_, (bf16_t*)(ws + OFF_WD), scr, lane, gw, NGW); }
    bar_t += G; gsync(bar, bar_t, wave_s);
    { pg8::StaticOrder so; so.init(S_, 512, G, bid);
      pg8::Gemm g{XN, (const bf16_t*)(ws + OFF_WMQ), S_, 512, D_};
      pg8::EpiBf16 e{(bf16_t*)(ws + OFF_QM), 512};
      pg8::gemm_phase(lds, g, so, e, wave_s); }
    if (bid >= 128) {
        PHASE_IDX();
        const int kw = (bid - 128) * 8 + wave, KNW = (G - 128) * 8;
        for (int task = kw; task < 1024; task += KNW) { const int mt = task >> 6, nt = task & 63; const int col = lane & 15, quad = lane >> 4;
            const f32x4 c = wave_tile_gemm((const bf16_t*)(ws + OFF_MEMN) + (size_t)mt * 16 * D_, D_, (const bf16_t*)(ws + OFF_WMKV) + (size_t)nt * 16 * D_, D_, D_, lane);
            const int cc = nt * 16 + col, key = mt * 16 + quad * 4;
            if (cc < 512) { bf16_t* K = (bf16_t*)(ws + OFF_KM);
#pragma unroll
                for (int r = 0; r < 4; ++r) K[(size_t)(key + r) * 512 + cc] = f2bf(c[r]); }
            else { bf16_t* V = (bf16_t*)(ws + OFF_VMT) + (size_t)(cc - 512) * 256 + key; u32x2 v; v.x = pk2(c[0], c[1]); v.y = pk2(c[2], c[3]); *(u32x2*)V = v; } }
    }
    bar_t += G; gsync(bar, bar_t, wave_s);
    { PHASE_IDX(); for (int task = gw; task < (S_ / 16) * 4; task += NGW) mem_attn_task(ws, task, lane); }
    bar_t += G; gsync(bar, bar_t, wave_s);
    { pg8::StaticOrder so; so.init(S_, D_, G, bid);
      pg8::Gemm g{(const bf16_t*)(ws + OFF_OM), (const bf16_t*)(ws + OFF_WMO), S_, D_, 512};
      pg8::EpiBf16 e{Y, D_};
      pg8::gemm_phase(lds, g, so, e, wave_s); }
    bar_t += G; gsync(bar, bar_t, wave_s);
    { PHASE_IDX(); norm_phase(p.out, Y, 1.0f, p.in[33], p.out, p.in[34], XN, lane, gw, NGW); }
    bar_t += G; gsync(bar, bar_t, wave_s);
    ffn_phases(bar, bar_t, lds, ws, XN, ACT, Y, G, bid, wave_s);
    { PHASE_IDX(); norm_phase(p.out, Y, 0.5f, p.in[38], p.out, nullptr, XN, lane, gw, NGW); }
}

extern "C" void kernel_launch(void* const* d_in, const int* in_sizes, int n_in, void* d_out, int out_size, void* d_ws, size_t ws_size, hipStream_t stream) {
    constexpr size_t kDynLds = 131072;
    static int grid_blocks = 0;
    if (!grid_blocks) {
        if (n_in != 39 || out_size != S_ * D_ || ws_size < WS_END) { fprintf(stderr, "kernel_launch: unexpected shapes n_in %d out %d ws %zu (need %zu)\n", n_in, out_size, ws_size, (size_t)WS_END); grid_blocks = -1; return; }
        int dev = 0, cus = 0, per_cu = 0;
        hipGetDevice(&dev);
        hipDeviceGetAttribute(&cus, hipDeviceAttributeMultiprocessorCount, dev);
        hipFuncSetAttribute((const void*)hymba_fwd, hipFuncAttributeMaxDynamicSharedMemorySize, (int)kDynLds);
        hipOccupancyMaxActiveBlocksPerMultiprocessor(&per_cu, (const void*)hymba_fwd, 512, kDynLds);
        if (per_cu < 1) per_cu = 1;
        grid_blocks = cus * per_cu;
        if (grid_blocks > 256) grid_blocks = 256;
    }
    if (grid_blocks < 0) return;
    Params p{};
    for (int i = 0; i < 39; ++i) p.in[i] = (const float*)d_in[i];
    p.out = (float*)d_out; p.ws = (unsigned char*)d_ws;
    if (hipMemsetAsync((unsigned char*)d_ws + OFF_CTR, 0, 1024, stream) != hipSuccess) { fprintf(stderr, "memset failed\n"); return; }
    void* args[] = {&p};
    hipError_t e = hipLaunchCooperativeKernel((const void*)hymba_fwd, dim3(grid_blocks), dim3(512), args, kDynLds, stream);
    if (e != hipSuccess) fprintf(stderr, "cooperative launch failed: %s (grid %d)\n", hipGetErrorString(e), grid_blocks);
}
```
